# Optimizing an MI355X kernel written in HIP

```python
import math
import jax
import jax.numpy as jnp
from jax import lax
import numpy as np


D_MODEL = 1024
BATCH = 4
SEQ = 8192
DEPTH = 2

GRID_W = 64
CTX_LEN = 256
N_MIXERS = 2
N_ATTN_LAYERS = (DEPTH + 1) // 2
N_POOL_LAYERS = DEPTH // 2
N_MOD = 6
N_HEADS = 8
HEAD_DIM = 64
V_DIM = 2 * HEAD_DIM
ROPE_THETA = 10000.0
Q_BLOCK = 128
POOL_WINDOWS = (2, 4, 8, 16)
N_POOL_GROUPS = 4
POOL_GROUP_DIM = D_MODEL // N_POOL_GROUPS
N_EXPERTS = 32
N_EXPERT_GROUPS = 4
EXPERTS_PER_GROUP = N_EXPERTS // N_EXPERT_GROUPS
TOP_K = 2
D_EXPERT = D_MODEL // 2
MOE_BLOCK = 256
NORM_EPS = 1e-6

kernel_name = 'hybrid_diffattn_pool_moe_dit'


def rms_norm(x, gain):
    xf = x.astype(jnp.float32)
    y = xf * lax.rsqrt(jnp.mean(xf * xf, axis=-1, keepdims=True) + NORM_EPS)
    return (y * gain.astype(jnp.float32)).astype(x.dtype)


def modulate(h, shift, scale):
    return h * (1 + scale) + shift


def rope_2d_tables(n_tokens, dtype):
    rows = n_tokens // GRID_W
    row = jnp.repeat(jnp.arange(rows, dtype=jnp.float32), GRID_W)
    col = jnp.tile(jnp.arange(GRID_W, dtype=jnp.float32), rows)
    half = HEAD_DIM // 2
    inv_freq = ROPE_THETA ** (-jnp.arange(0, half, 2, dtype=jnp.float32) / half)
    ang_r = row[:, None] * inv_freq
    ang_c = col[:, None] * inv_freq
    ang = jnp.concatenate([ang_r, ang_r, ang_c, ang_c], axis=-1)
    return jnp.cos(ang).astype(dtype), jnp.sin(ang).astype(dtype)


def apply_rope_2d(x, cos, sin):
    x1, x2, x3, x4 = jnp.split(x, 4, axis=-1)
    rot = jnp.concatenate([-x2, x1, -x4, x3], axis=-1)
    return x * cos + rot * sin


def diff_attention(h, hc, w_in, w_out, q_gain, k_gain, lam, lam_init, sub_gain, cos, sin, ctx_out):
    B, L, D = h.shape
    C = hc.shape[1]

    def qk_heads(t, n):
        return t.reshape(B, n, N_HEADS, 2, HEAD_DIM).transpose(0, 2, 3, 1, 4)

    def v_heads(t, n):
        return t.reshape(B, n, N_HEADS, V_DIM).transpose(0, 2, 1, 3)

    q, k, v = jnp.split(h @ w_in, 3, axis=-1)
    q = apply_rope_2d(rms_norm(qk_heads(q, L), q_gain), cos, sin)
    k = apply_rope_2d(rms_norm(qk_heads(k, L), k_gain), cos, sin)
    v = v_heads(v, L)
    kc, vc = jnp.split(hc @ w_in[:, D:], 2, axis=-1)
    kc = rms_norm(qk_heads(kc, C), k_gain)
    vc = v_heads(vc, C)
    k_all = jnp.concatenate([k, kc], axis=3)
    v_all = jnp.concatenate([v, vc], axis=2)
    scale = HEAD_DIM ** -0.5

    def attend(q_blk, keys, vals):
        s = jnp.einsum('bhmqd,bhmkd->bhmqk', q_blk, keys).astype(jnp.float32) * scale
        p = jax.nn.softmax(s, axis=-1)
        w = (p[:, :, 0] - lam * p[:, :, 1]).astype(vals.dtype)
        return jnp.einsum('bhqk,bhkv->bhqv', w, vals)

    def finish(o):
        o = rms_norm(o, sub_gain) * (1 - lam_init)
        return o.reshape(o.shape[0], o.shape[1], N_HEADS * V_DIM) @ w_out

    n_blk = L // Q_BLOCK
    q_blocks = q.reshape(B, N_HEADS, 2, n_blk, Q_BLOCK, HEAD_DIM).transpose(3, 0, 1, 2, 4, 5)
    o = lax.map(lambda qb: attend(qb, k_all, v_all), q_blocks)
    y = finish(o.transpose(1, 0, 3, 2, 4).reshape(B, L, N_HEADS, V_DIM))
    yc = None
    if ctx_out:
        qc = rms_norm(qk_heads(hc @ w_in[:, :D], C), q_gain)
        yc = finish(attend(qc, kc, vc).transpose(0, 2, 1, 3))
    return y, yc


def pool_mixer(h, w_in, w_group, ch_scale, w_out):
    B, L, D = h.shape
    u = h @ w_in
    cs = jnp.concatenate([jnp.zeros((B, 1, D), jnp.float32),
                          jnp.cumsum(u.astype(jnp.float32), axis=1)], axis=1)
    t = jnp.arange(L)
    outs = []
    for g, win in enumerate(POOL_WINDOWS):
        sl = slice(g * POOL_GROUP_DIM, (g + 1) * POOL_GROUP_DIM)
        lo = jnp.maximum(t - win // 2, 0)
        hi = jnp.minimum(t + win // 2, L)
        cs_g = cs[:, :, sl]
        mean = (jnp.take(cs_g, hi, axis=1) - jnp.take(cs_g, lo, axis=1)) / (hi - lo).astype(jnp.float32)[None, :, None]
        d = (mean - u[:, :, sl].astype(jnp.float32)).astype(h.dtype)
        outs.append(d @ w_group[g])
    y = jnp.concatenate(outs, axis=-1) * ch_scale
    return y @ w_out


def route(h_flat, router_w, router_b):
    n = h_flat.shape[0]
    logits = (h_flat @ router_w).astype(jnp.float32) + router_b.astype(jnp.float32)
    probs = jax.nn.softmax(logits, axis=-1).reshape(n, N_EXPERT_GROUPS, EXPERTS_PER_GROUP)
    group_score = lax.top_k(probs, TOP_K)[0].sum(-1)
    g_sel = jnp.argmax(group_score, axis=-1)
    in_group = probs[jnp.arange(n), g_sel]
    vals, idx = lax.top_k(in_group, TOP_K)
    experts = g_sel[:, None] * EXPERTS_PER_GROUP + idx
    gates = vals / jnp.sum(vals, axis=-1, keepdims=True)
    return experts, gates


def moe(h_flat, router_w, router_b, w_gate, w_up, w_down):
    n, d = h_flat.shape
    experts, gates = route(h_flat, router_w, router_b)
    a = n * TOP_K
    flat_e = experts.reshape(-1)
    flat_tok = jnp.repeat(jnp.arange(n, dtype=jnp.int32), TOP_K)
    flat_gate = gates.reshape(-1)
    order = jnp.argsort(flat_e)
    sorted_e = flat_e[order]
    counts = jnp.bincount(flat_e, length=N_EXPERTS)
    padded = (counts + MOE_BLOCK - 1) // MOE_BLOCK * MOE_BLOCK
    start = jnp.cumsum(counts) - counts
    pad_end = jnp.cumsum(padded)
    pad_start = pad_end - padded
    dest = pad_start[sorted_e] + jnp.arange(a) - start[sorted_e]
    n_blocks = -(-a // MOE_BLOCK) + N_EXPERTS
    n_slots = n_blocks * MOE_BLOCK
    slot_tok = jnp.full((n_slots,), n, jnp.int32).at[dest].set(flat_tok[order])
    slot_gate = jnp.zeros((n_slots,), jnp.float32).at[dest].set(flat_gate[order])
    block_start = jnp.arange(n_blocks) * MOE_BLOCK
    block_e = jnp.minimum(jnp.sum(pad_end[None, :] <= block_start[:, None], axis=1), N_EXPERTS - 1)
    h_pad = jnp.concatenate([h_flat, jnp.zeros((1, d), h_flat.dtype)], axis=0)
    xs = h_pad[slot_tok].reshape(n_blocks, MOE_BLOCK, d)

    def expert_block(args):
        xb, e = args
        return (jax.nn.silu(xb @ w_gate[e]) * (xb @ w_up[e])) @ w_down[e]

    ys = lax.map(expert_block, (xs, block_e)).reshape(n_slots, d)
    ys = ys * slot_gate[:, None].astype(ys.dtype)
    return jax.ops.segment_sum(ys, slot_tok, num_segments=n + 1)[:n]


def setup_inputs(seed: int = 0) -> dict:
    key = jax.random.key(seed)
    ks = jax.random.split(key, 26)
    f32 = jnp.float32
    D = D_MODEL
    G = POOL_GROUP_DIM

    def nrm(k, shape, scale):
        return jax.random.normal(k, shape, f32) * scale

    return {
        'x': nrm(ks[0], (BATCH, SEQ, D), 1.0),
        'c': nrm(ks[1], (BATCH, D), 1.0),
        'ctx': nrm(ks[2], (BATCH, CTX_LEN, D), 1.0),
        'c_ctx': nrm(ks[3], (D,), 1.0),
        'ada_w': nrm(ks[4], (DEPTH, D, N_MOD * D), 0.5 * D ** -0.5),
        'ada_b': nrm(ks[5], (DEPTH, N_MOD * D), 0.01),
        'norm1_g': 1.0 + nrm(ks[6], (DEPTH, D), 0.05),
        'norm2_g': 1.0 + nrm(ks[7], (DEPTH, D), 0.05),
        'attn_w_in': nrm(ks[8], (N_ATTN_LAYERS, D, 3 * D), D ** -0.5),
        'attn_w_out': nrm(ks[9], (N_ATTN_LAYERS, N_HEADS * V_DIM, D), (N_HEADS * V_DIM) ** -0.5),
        'attn_q_gain': 1.0 + nrm(ks[10], (N_ATTN_LAYERS, HEAD_DIM), 0.05),
        'attn_k_gain': 1.0 + nrm(ks[11], (N_ATTN_LAYERS, HEAD_DIM), 0.05),
        'attn_lq1': nrm(ks[12], (N_ATTN_LAYERS, HEAD_DIM), 0.1),
        'attn_lk1': nrm(ks[13], (N_ATTN_LAYERS, HEAD_DIM), 0.1),
        'attn_lq2': nrm(ks[14], (N_ATTN_LAYERS, HEAD_DIM), 0.1),
        'attn_lk2': nrm(ks[15], (N_ATTN_LAYERS, HEAD_DIM), 0.1),
        'attn_sub_gain': 1.0 + nrm(ks[16], (N_ATTN_LAYERS, V_DIM), 0.05),
        'pool_w_in': nrm(ks[17], (N_POOL_LAYERS, D, D), D ** -0.5),
        'pool_w_group': nrm(ks[18], (N_POOL_LAYERS, N_POOL_GROUPS, G, G), G ** -0.5),
        'pool_scale': 1.0 + nrm(ks[19], (N_POOL_LAYERS, D), 0.1),
        'pool_w_out': nrm(ks[20], (N_POOL_LAYERS, D, D), D ** -0.5),
        'router_w': nrm(ks[21], (D, N_EXPERTS), D ** -0.5),
        'router_b': nrm(ks[22], (N_EXPERTS,), 0.01),
        'moe_w_gate': nrm(ks[23], (DEPTH, N_EXPERTS, D, D_EXPERT), D ** -0.5),
        'moe_w_up': nrm(ks[24], (DEPTH, N_EXPERTS, D, D_EXPERT), D ** -0.5),
        'moe_w_down': nrm(ks[25], (DEPTH, N_EXPERTS, D_EXPERT, D), D_EXPERT ** -0.5),
    }


def reference(x, c, ctx, c_ctx, ada_w, ada_b, norm1_g, norm2_g,
              attn_w_in, attn_w_out, attn_q_gain, attn_k_gain,
              attn_lq1, attn_lk1, attn_lq2, attn_lk2, attn_sub_gain,
              pool_w_in, pool_w_group, pool_scale, pool_w_out,
              router_w, router_b, moe_w_gate, moe_w_up, moe_w_down):
    B, L, D = x.shape
    cos, sin = rope_2d_tables(L, x.dtype)
    c_act = jax.nn.silu(c)
    cc_act = jax.nn.silu(c_ctx)
    for i in range(DEPTH):
        kind = i % N_MIXERS
        j = i // N_MIXERS
        update_ctx = any(l % N_MIXERS == 0 for l in range(i + 1, DEPTH))
        need_ctx_in = (kind == 0) or update_ctx
        mod = (c_act @ ada_w[i] + ada_b[i])[:, None, :]
        sh1, s1, g1, sh2, s2, g2 = jnp.split(mod, N_MOD, axis=-1)
        h = modulate(rms_norm(x, norm1_g[i]), sh1, s1)
        if need_ctx_in:
            mod_c = cc_act @ ada_w[i] + ada_b[i]
            csh1, cs1, cg1, csh2, cs2, cg2 = jnp.split(mod_c, N_MOD, axis=-1)
            hc = modulate(rms_norm(ctx, norm1_g[i]), csh1, cs1)
        if kind == 0:
            lam_init = 0.8 - 0.6 * math.exp(-0.3 * i)
            f32 = jnp.float32
            lam = (jnp.exp(jnp.sum(attn_lq1[j].astype(f32) * attn_lk1[j].astype(f32)))
                   - jnp.exp(jnp.sum(attn_lq2[j].astype(f32) * attn_lk2[j].astype(f32))) + lam_init)
            y, yc = diff_attention(h, hc, attn_w_in[j], attn_w_out[j], attn_q_gain[j], attn_k_gain[j],
                                   lam, lam_init, attn_sub_gain[j], cos, sin, update_ctx)
        else:
            y = pool_mixer(h, pool_w_in[j], pool_w_group[j], pool_scale[j], pool_w_out[j])
            yc = pool_mixer(hc, pool_w_in[j], pool_w_group[j], pool_scale[j], pool_w_out[j]) if update_ctx else None
        x = x + g1 * y
        h2 = modulate(rms_norm(x, norm2_g[i]), sh2, s2)
        if update_ctx:
            ctx = ctx + cg1 * yc
            h2c = modulate(rms_norm(ctx, norm2_g[i]), csh2, cs2)
            tokens = jnp.concatenate([h2.reshape(-1, D), h2c.reshape(-1, D)], axis=0)
            out = moe(tokens, router_w, router_b, moe_w_gate[i], moe_w_up[i], moe_w_down[i])
            x = x + g2 * out[:B * L].reshape(B, L, D)
            ctx = ctx + cg2 * out[B * L:].reshape(ctx.shape)
        else:
            out = moe(h2.reshape(-1, D), router_w, router_b, moe_w_gate[i], moe_w_up[i], moe_w_down[i])
            x = x + g2 * out.reshape(B, L, D)
    return x
```

```cpp
#include <hip/hip_runtime.h>
#include <hip/hip_cooperative_groups.h>
#include <cstdio>
#include <cstdint>
namespace cg = cooperative_groups;

#define LAS __attribute__((address_space(3)))
#define DI __device__ __forceinline__
typedef unsigned short bf16_t;
typedef short bf16x8 __attribute__((ext_vector_type(8)));
typedef float f32x4 __attribute__((ext_vector_type(4)));
typedef float f32x16 __attribute__((ext_vector_type(16)));
typedef float f32x2_t __attribute__((ext_vector_type(2)));
typedef __bf16 bf16x2_t __attribute__((ext_vector_type(2)));
typedef unsigned u32x4 __attribute__((ext_vector_type(4)));
typedef unsigned u32x2 __attribute__((ext_vector_type(2)));
typedef int v8i_t __attribute__((ext_vector_type(8)));

constexpr int D = 1024, NB = 4, SEQ = 8192, CTXL = 256, KV = SEQ + CTXL  , NTOK = NB * SEQ  , NROWS = NB * KV  ;
constexpr int NH = 8, HD = 64, VD = 128, NE = 32, DE = 512, NKT = KV / 64  ;
constexpr int NASSIGN = NTOK * 2;
constexpr float EPS = 1e-6f;
constexpr float LOG2E = 1.4426950408889634f;
constexpr float C2 = 0.125f * LOG2E;

constexpr int LDS_STG_OFF = 131072 + 2304;
constexpr size_t MiB = 1u << 20;
constexpr size_t WS_CTL = 0;
constexpr size_t WS_SMALL = 1 * MiB;
constexpr size_t WS_LIST = 2 * MiB;
constexpr size_t WS_TOKSLOT = 1 * MiB + 512 * 1024;
constexpr size_t WS_ROWSS = 10 * MiB;
constexpr size_t WS_WQK = 12 * MiB;
constexpr size_t WS_WPF = 14 * MiB;
constexpr size_t WS_WV = 16 * MiB;
constexpr size_t WS_WO = 18 * MiB;
constexpr size_t WS_WPI = 20 * MiB;
constexpr size_t WS_WPG = 22 * MiB;
constexpr size_t WS_WPO = 23 * MiB;
constexpr size_t WS_WR = 25 * MiB;
constexpr size_t WS_WGU = 26 * MiB;
constexpr size_t WS_WD = 154 * MiB;
constexpr size_t WS_R0 = 218 * MiB;
constexpr size_t WS_R1 = 284 * MiB;
constexpr size_t WS_R2 = 348 * MiB;
constexpr size_t WS_R3 = 414 * MiB;
constexpr size_t WS_XR = 480 * MiB;
constexpr size_t WS_END = 544 * MiB;
constexpr int CW_BAR = 4096;
constexpr int CW_WQ = 512;
constexpr int CW_CNT = 1024, CW_CNT_STRIDE = 32;
constexpr int SM_MOD = 0;
constexpr int SM_MODC = 2 * 4 * 6144;
constexpr int SM_SCAL = SM_MODC + 2048;
constexpr int SM_ROPE = SM_SCAL + 64;

struct Params {
  const float *x, *c, *ctx, *c_ctx, *ada_w, *ada_b, *n1g, *n2g, *w_in, *w_out, *qg, *kg, *lq1, *lk1, *lq2, *lk2, *subg,
      *pw_in, *pw_g, *pscale, *pw_out, *rw, *rb, *wg, *wu, *wd;
  float* out; unsigned char* ws;
  int ph_lo, ph_hi;
};

DI unsigned cvtpk(float lo, float hi) { f32x2_t v = {lo, hi}; bf16x2_t b = __builtin_convertvector(v, bf16x2_t); return __builtin_bit_cast(unsigned, b); }
DI unsigned pk4_fp8(float a, float b, float c, float d) { int w = 0; w = __builtin_amdgcn_cvt_pk_fp8_f32(a, b, w, false); w = __builtin_amdgcn_cvt_pk_fp8_f32(c, d, w, true); return (unsigned)w; }
DI float bf2f(unsigned short u) { return __uint_as_float(((unsigned)u) << 16); }
DI float wave_sum(float v) {
#pragma unroll
  for (int o = 1; o < 64; o <<= 1) v += __shfl_xor(v, o);
  return v;
}
DI float silu_f(float v) { return v / (1.f + __expf(-v)); }

DI int opaque_tid() { int t = threadIdx.x; asm volatile("" : "+v"(t)); return t; }
#define GAS __attribute__((address_space(1)))
#define WSP ({ GAS unsigned char* w_ = (GAS unsigned char*)p.ws; asm volatile("" : "+s"(w_)); (unsigned char*)w_; })


#define XB_TMO      128
#define XB_XCNT(j)  (256  + 64 * (j))
#define XB_XSUB(j)  (1280 + 64 * (j))
#define XB_XGEN(j)  (2304 + 64 * (j))
#define XB_TOP      3328
#define XB_TOPGEN   3392
#define XCD_BAR_WORDS 3456
#define XB_SPIN_CAP (1u << 18)
DI unsigned xb_ld(unsigned* p)              { return __hip_atomic_load(p, __ATOMIC_RELAXED, __HIP_MEMORY_SCOPE_AGENT); }
DI unsigned xb_add(unsigned* p, unsigned v) { return __hip_atomic_fetch_add(p, v, __ATOMIC_RELAXED, __HIP_MEMORY_SCOPE_AGENT); }
DI unsigned xb_xcc_id() { return (unsigned)__builtin_amdgcn_s_getreg((3 << 11) | 20) & 0xFu; }
#define XB_SPIN(cond, bar) do { unsigned _sp = 0; while (cond) { __builtin_amdgcn_s_sleep(1); \
    if ((++_sp & 255u) == 0u) { if (xb_ld(&(bar)[XB_TMO])) break; if (_sp > XB_SPIN_CAP) { atomicAdd(&(bar)[XB_TMO], 1u); break; } } } } while (0)
struct XcdBarrier { unsigned* bar; unsigned x; volatile LAS unsigned* st; };
DI XcdBarrier xcd_barrier_post(unsigned* bar, volatile LAS unsigned* st) {
  XcdBarrier b; b.bar = bar; b.x = xb_xcc_id(); b.st = st;
  if (threadIdx.x == 0) (void)xb_add(&bar[XB_XCNT(b.x)], 1u);
  return b;
}
DI void xcd_barrier_complete(unsigned* bar, unsigned x, unsigned& nloc, unsigned& nx) {
  const unsigned G = gridDim.x * gridDim.y * gridDim.z;
  unsigned sum, cnt, mine, sp = 0u;
  for (;;) {
    sum = 0u; cnt = 0u; mine = 0u;
#pragma unroll
    for (unsigned j = 0; j < 16; ++j) { const unsigned c = xb_ld(&bar[XB_XCNT(j)]); sum += c; cnt += (c > 0u) ? 1u : 0u; mine = (j == x) ? c : mine; }
    if (sum == G) break;
    __builtin_amdgcn_s_sleep(1);
    if ((++sp & 255u) == 0u) { if (xb_ld(&bar[XB_TMO])) break; if (sp > XB_SPIN_CAP) { atomicAdd(&bar[XB_TMO], 1u); break; } }
  }
  nloc = mine > 0u ? mine : 1u; nx = cnt > 0u ? cnt : 1u;
}
DI void xcd_barrier(const XcdBarrier& b) {
  asm volatile("s_waitcnt vmcnt(0)" ::: "memory");
  __syncthreads();
  if (threadIdx.x == 0) {
    unsigned* bar = b.bar;
    __builtin_amdgcn_s_waitcnt(0);
    unsigned nloc = b.st[0], nx = b.st[1];
    if (nloc == 0u) { xcd_barrier_complete(bar, b.x, nloc, nx); b.st[0] = nloc; b.st[1] = nx; }
    const unsigned old = xb_add(&bar[XB_XSUB(b.x)], 1u);
    const unsigned gen = old / nloc;
    if (old + 1u == (gen + 1u) * nloc) {
      __builtin_amdgcn_fence(__ATOMIC_RELEASE, "agent");
      asm volatile("s_waitcnt vmcnt(0)" ::: "memory");
      const unsigned og = xb_add(&bar[XB_TOP], 1u);
      const unsigned tg = og / nx;
      if (og + 1u == (tg + 1u) * nx) xb_add(&bar[XB_TOPGEN], 1u);
      else XB_SPIN(xb_ld(&bar[XB_TOPGEN]) == tg, bar);
      xb_add(&bar[XB_XGEN(b.x)], 1u);
      __builtin_amdgcn_fence(__ATOMIC_ACQUIRE, "agent");
      asm volatile("s_waitcnt vmcnt(0)" ::: "memory");
    } else {
      XB_SPIN(xb_ld(&bar[XB_XGEN(b.x)]) == gen, bar);
      __builtin_amdgcn_fence(__ATOMIC_ACQUIRE, "agent");
      asm volatile("s_waitcnt vmcnt(0)" ::: "memory");
    }
  }
  __syncthreads();
}

namespace pg8 {
constexpr int BM = 256, BK = 64, HALF = 128, HTB = HALF * BK * 2, STAGE_BYTES = 8 * HTB;
DI int lds_byte(int r, int c) { const int st = (r >> 4) * 2 + (c >> 5), rr = r & 15, cc = c & 31, ob = rr * 64 + cc * 2; return st * 1024 + (ob ^ (((ob >> 9) & 1) << 5)); }
DI void stage_rc(int b, int& R, int& C) { const int st = b / 1024, sb = b % 1024, swz = sb ^ (((sb >> 9) & 1) << 5); R = (st >> 1) * 16 + swz / 64; C = (st & 1) * 32 + (swz % 64) / 2; }

DI void glds16s(const char* sbase_, unsigned voff, unsigned lds_dst) { unsigned keep;
  const char* sbase = (const char*)(((size_t)(unsigned)__builtin_amdgcn_readfirstlane((int)((size_t)sbase_ >> 32)) << 32) | (size_t)(unsigned)__builtin_amdgcn_readfirstlane((int)(size_t)sbase_));
  asm volatile("s_nop 2\n\ts_mov_b32 %0, m0\n\ts_mov_b32 m0, %3\n\ts_nop 0\n\tglobal_load_lds_dwordx4 %1, %2\n\ts_mov_b32 m0, %0" : "=&s"(keep) : "v"(voff), "s"(sbase), "s"(lds_dst) : "memory"); }
struct Unit { const char* A; const char* B; int i0, i1, i2, i3; };

struct PermNone { static constexpr int HALF_ROWS = 128; static DI int src(int s) { return s; } };
struct Perm8 { static constexpr int HALF_ROWS = 128; static DI int src(int s) { const int r = s & 31, n = r >> 4, i = r & 15; return (s & ~31) + 8 * (i >> 2) + 4 * n + (i & 3); } };
struct PermQK { static constexpr int HALF_ROWS = 4; static DI int src(int s) { return (((s >> 5) & 3) << 6) | (((s >> 3) & 1) << 5) | (((s >> 4) & 1) << 4) | (((s >> 2) & 1) << 3) | (((s >> 7) & 1) << 2) | (s & 3); } };
struct PermV { static constexpr int HALF_ROWS = 16; static DI int src(int s) { return (((s >> 5) & 3) << 6) | (((s >> 3) & 1) << 5) | (((s >> 7) & 1) << 4) | (((s >> 4) & 1) << 3) | (((s >> 2) & 1) << 2) | (s & 3); } };

template <class Epi, class Sched, class BPerm, bool GATHER, class BPerm1 = BPerm, bool DYNB = false, bool FP8 = false, bool HALFSKIP = false>
DI void gemm_phase(LAS unsigned char* lds, const int lda  , const int ldb  , const int K, const Sched& S, const Epi& E) {
  int tid_ = threadIdx.x; asm volatile("" : "+v"(tid_));
  const int tid = tid_, wid = __builtin_amdgcn_readfirstlane(tid >> 6), lane = tid & 63, wr = wid >> 2, wc = wid & 3, fr = lane & 15, fq = lane >> 4;
  int Kk = K; asm volatile("" : "+s"(Kk));
  const int nt = FP8 ? Kk / 128 : Kk / BK;
  int sR[2], sC[2];
#pragma unroll
  for (int i = 0; i < 2; ++i) stage_rc(tid * 16 + i * 8192, sR[i], sC[i]);
  unsigned vA[2][2], vAn[2][2], vB[2], vBn[2];
#pragma unroll
  for (int i = 0; i < 2; ++i) { vB[i] = (unsigned)(BPerm::src(sR[i]) * ldb + sC[i] * 2); vBn[i] = vB[i]; vA[0][i] = (unsigned)(sR[i] * lda + sC[i] * 2); vA[1][i] = vA[0][i]; vAn[0][i] = vA[0][i]; vAn[1][i] = vA[0][i]; }
  const size_t kstep = (size_t)(BK * 2);
  const size_t hA = GATHER ? (size_t)0 : (size_t)128 * lda; size_t hB = (size_t)BPerm::HALF_ROWS * ldb, hBn = hB;
  const unsigned ldsw = (unsigned)wid * 1024u;
  const int aoff = lds_byte(wr * 64 + fr, fq * 8), boff = lds_byte(wc * 32 + fr, fq * 8);
#define PG8_SA(b, h) (((b) * 2 + (h)) * HTB)
#define PG8_SB(b, h) ((4 + (b) * 2 + (h)) * HTB)
#define PG8_STAGE(bufoff, gbase, v0, v1) do { \
    glds16s((const char*)(gbase), (v0), (unsigned)__builtin_amdgcn_readfirstlane((int)((unsigned)(size_t)lds + (unsigned)(bufoff) + ldsw))); \
    glds16s((const char*)(gbase), (v1), (unsigned)__builtin_amdgcn_readfirstlane((int)((unsigned)(size_t)lds + (unsigned)(bufoff) + ldsw + 8192u))); } while (0)
#define PG8_STA(b, h, base, W) PG8_STAGE(PG8_SA(b, h), (base) + (h) * hA, W[GATHER ? (h) : 0][0], W[GATHER ? (h) : 0][1])
#define PG8_STB(b, h, base) PG8_STAGE(PG8_SB(b, h), (base) + (h) * hB, vB[0], vB[1])
#define PG8_STB2(b, h, base) PG8_STAGE(PG8_SB(b, h), (base) + (h) * hB2, vB2[0], vB2[1])
#define PG8_RD(off) (*(const LAS u32x4*)(lds + (off)))
#define PG8_CAT2(lo, hi) __builtin_bit_cast(v8i_t, __builtin_shufflevector((lo), (hi), 0, 1, 2, 3, 4, 5, 6, 7))
#define PG8_LDA(dst, b, h) do { _Pragma("unroll") for (int m = 0; m < 4; ++m) dst[m] = PG8_CAT2(PG8_RD(PG8_SA(b, h) + aoff + m * 2048), PG8_RD(PG8_SA(b, h) + aoff + m * 2048 + 1024)); } while (0)
#define PG8_LDB(dst, b, h) do { _Pragma("unroll") for (int n = 0; n < 2; ++n) dst[n] = PG8_CAT2(PG8_RD(PG8_SB(b, h) + boff + n * 2048), PG8_RD(PG8_SB(b, h) + boff + n * 2048 + 1024)); } while (0)
#define PG8_LO(X) __builtin_bit_cast(bf16x8, __builtin_shufflevector((X), (X), 0, 1, 2, 3))
#define PG8_HI(X) __builtin_bit_cast(bf16x8, __builtin_shufflevector((X), (X), 4, 5, 6, 7))
#define PG8_MMA(ai, bj, At, Bt) do { __builtin_amdgcn_s_setprio(1); \
      if constexpr (FP8) { _Pragma("unroll") for (int m = 0; m < 4; ++m) _Pragma("unroll") for (int n = 0; n < 2; ++n) \
        asm volatile("v_mfma_scale_f32_16x16x128_f8f6f4 %0, %1, %2, %0, %3, %4 op_sel_hi:[0,0,0]" : "+v"(acc[ai][bj][m][n]) : "v"(Bt[n]), "v"(At[m]), "v"(scw), "v"(sca)); } \
      else { _Pragma("unroll") for (int m = 0; m < 4; ++m) _Pragma("unroll") for (int n = 0; n < 2; ++n) { \
        acc[ai][bj][m][n] = __builtin_amdgcn_mfma_f32_16x16x32_bf16(PG8_LO(Bt[n]), PG8_LO(At[m]), acc[ai][bj][m][n], 0, 0, 0); \
        acc[ai][bj][m][n] = __builtin_amdgcn_mfma_f32_16x16x32_bf16(PG8_HI(Bt[n]), PG8_HI(At[m]), acc[ai][bj][m][n], 0, 0, 0); } } \
      __builtin_amdgcn_s_setprio(0); } while (0)
#define PG8_WAIT_V(n) asm volatile("s_waitcnt vmcnt(" #n ")" ::: "memory")
#define PG8_WAIT_L(n) asm volatile("s_waitcnt lgkmcnt(" #n ")" ::: "memory")
#define PG8_BAR __builtin_amdgcn_s_barrier()
#define PG8_SCHED __builtin_amdgcn_sched_barrier(0)
  Unit cur, nxt; int ui = 0;
  if (!S.next(0, cur)) return;
  if constexpr (GATHER) {
#pragma unroll
    for (int h = 0; h < 2; ++h)
#pragma unroll
      for (int i = 0; i < 2; ++i) { vA[h][i] = (unsigned)(S.arow(cur, 128 * h + sR[i]) * lda + sC[i] * 2); vAn[h][i] = vA[h][i]; }
  }
  if constexpr (DYNB) { if (S.bkind(cur)) {
#pragma unroll
      for (int i = 0; i < 2; ++i) vB[i] = (unsigned)(BPerm1::src(sR[i]) * ldb + sC[i] * 2);
      hB = (size_t)BPerm1::HALF_ROWS * ldb; }
    vBn[0] = vB[0]; vBn[1] = vB[1]; hBn = hB; }
  f32x4 acc[2][2][4][2];
#pragma unroll
  for (int a = 0; a < 2; ++a)
#pragma unroll
    for (int b = 0; b < 2; ++b)
#pragma unroll
      for (int m = 0; m < 4; ++m)
#pragma unroll
        for (int n = 0; n < 2; ++n) acc[a][b][m][n] = (f32x4){0.f, 0.f, 0.f, 0.f};
  int scw = 122, sca = 127;
  asm volatile("" : "+v"(scw), "+v"(sca));
  v8i_t At[4], B0[2], B1[2];
  const char* cA = cur.A; const char* cB = cur.B;
  PG8_STB(0, 0, cB); PG8_STB(0, 1, cB); PG8_STA(0, 0, cA, vA); PG8_STA(0, 1, cA, vA);
  if (wr == 1) PG8_BAR;
  PG8_WAIT_V(2); PG8_BAR;
  PG8_STB(1, 0, cB + kstep); PG8_STA(1, 0, cA + kstep, vA); PG8_STB(1, 1, cB + kstep);
  PG8_WAIT_V(6); PG8_BAR;
  for (;;) {
    const bool has_next = S.next(ui + 1, nxt);
    const char* nA = has_next ? nxt.A : cA; const char* nB = has_next ? nxt.B : cB;
    if constexpr (DYNB) {
      if (has_next) { const bool k1 = S.bkind(nxt);
#pragma unroll
        for (int i = 0; i < 2; ++i) { int r_, c_; stage_rc(opaque_tid() * 16 + i * 8192, r_, c_); vBn[i] = (unsigned)((k1 ? BPerm1::src(r_) : BPerm::src(r_)) * ldb + c_ * 2); }
        hBn = (size_t)(k1 ? BPerm1::HALF_ROWS : BPerm::HALF_ROWS) * ldb; }
    }
    if constexpr (GATHER) {
      if (has_next) {
#pragma unroll
        for (int h = 0; h < 2; ++h)
#pragma unroll
          for (int i = 0; i < 2; ++i) { int r_, c_; stage_rc(opaque_tid() * 16 + i * 8192, r_, c_); vAn[h][i] = (unsigned)(S.arow(nxt, 128 * h + r_) * lda + c_ * 2); }
      }
    }
    const bool full_ = !HALFSKIP || (__builtin_amdgcn_readfirstlane(cur.i1) > 128);
    for (int t = 0; t < nt; t += 2) {
      const bool last = (t == nt - 2);
      const char* a1 = cA + (size_t)(t + 1) * kstep;
      const char* a2 = last ? nA : cA + (size_t)(t + 2) * kstep; const char* b2 = last ? nB : cB + (size_t)(t + 2) * kstep;
      const char* a3 = a2 + kstep; const char* b3 = b2 + kstep;
      unsigned w2[2][2];
#pragma unroll
      for (int h = 0; h < 2; ++h)
#pragma unroll
        for (int i = 0; i < 2; ++i) w2[h][i] = (GATHER && last) ? vAn[h][i] : vA[h][i];
      unsigned vB2[2]; size_t hB2 = hB;
#pragma unroll
      for (int i = 0; i < 2; ++i) vB2[i] = (DYNB && last) ? vBn[i] : vB[i];
      if (DYNB && last) hB2 = hBn;
      PG8_LDB(B0, 0, 0); PG8_LDB(B1, 0, 1); PG8_SCHED; PG8_LDA(At, 0, 0); PG8_STA(1, 1, a1, vA);
      PG8_WAIT_V(8); PG8_WAIT_L(0); PG8_BAR; PG8_MMA(0, 0, At, B0); PG8_MMA(0, 1, At, B1); PG8_BAR; PG8_SCHED;
      if (full_) { PG8_LDA(At, 0, 1); } PG8_STB2(0, 0, b2); PG8_STB2(0, 1, b2); PG8_STA(0, 0, a2, w2);
      PG8_WAIT_V(8); PG8_WAIT_L(0); PG8_BAR; if (full_) { PG8_MMA(1, 0, At, B0); PG8_MMA(1, 1, At, B1); } PG8_BAR; PG8_SCHED;
      PG8_LDB(B0, 1, 0); PG8_LDB(B1, 1, 1); PG8_SCHED; PG8_LDA(At, 1, 0); PG8_STA(0, 1, a2, w2);
      PG8_WAIT_V(8); PG8_WAIT_L(0); PG8_BAR; PG8_MMA(0, 0, At, B0); PG8_MMA(0, 1, At, B1); PG8_BAR; PG8_SCHED;
      if (full_) { PG8_LDA(At, 1, 1); } PG8_STB2(1, 0, b3); PG8_STB2(1, 1, b3); PG8_STA(1, 0, a3, w2);
      PG8_WAIT_V(8); PG8_WAIT_L(0); PG8_BAR; if (full_) { PG8_MMA(1, 0, At, B0); PG8_MMA(1, 1, At, B1); } PG8_BAR; PG8_SCHED;
    }
    if (wr == 0) PG8_BAR;
    if constexpr (FP8) {
#define PG8_T4(ai, bj) "+v"(acc[ai][bj][0][0]), "+v"(acc[ai][bj][0][1]), "+v"(acc[ai][bj][1][0]), "+v"(acc[ai][bj][1][1]), "+v"(acc[ai][bj][2][0]), "+v"(acc[ai][bj][2][1]), "+v"(acc[ai][bj][3][0]), "+v"(acc[ai][bj][3][1])
      asm volatile("s_nop 15\n\ts_nop 15" : PG8_T4(0, 0), PG8_T4(0, 1) :: "memory");
      asm volatile("" : PG8_T4(1, 0), PG8_T4(1, 1) :: "memory");
#undef PG8_T4
    }
    if constexpr (Epi::STAGED) E.staged(acc, cur, wr, wc, fr, fq, lds); else E(acc, cur, wr, wc, fr, fq);
    if (!has_next) break;
#pragma unroll
    for (int a = 0; a < 2; ++a)
#pragma unroll
      for (int b = 0; b < 2; ++b)
#pragma unroll
        for (int m = 0; m < 4; ++m)
#pragma unroll
          for (int n = 0; n < 2; ++n) acc[a][b][m][n] = (f32x4){0.f, 0.f, 0.f, 0.f};
    cur = nxt; cA = nA; cB = nB; ++ui;
    if constexpr (DYNB) { vB[0] = vBn[0]; vB[1] = vBn[1]; hB = hBn; }
    if constexpr (GATHER) {
#pragma unroll
      for (int h = 0; h < 2; ++h)
#pragma unroll
        for (int i = 0; i < 2; ++i) vA[h][i] = vAn[h][i];
    }
    if (wr == 1) PG8_BAR;
  }
  PG8_WAIT_V(0);
  PG8_BAR;
#undef PG8_SA
#undef PG8_SB
#undef PG8_STAGE
#undef PG8_STA
#undef PG8_STB
#undef PG8_STB2
#undef PG8_LDA
#undef PG8_LDB
#undef PG8_MMA
#undef PG8_RD
#undef PG8_CAT2
#undef PG8_LO
#undef PG8_HI
#undef PG8_WAIT_V
#undef PG8_WAIT_L
#undef PG8_BAR
#undef PG8_SCHED
}
}
using pg8::Unit;

struct Deal {
  int x, j, Ux, U;
  DI void init(int U_) { const int G = gridDim.x, bx = blockIdx.x; int v = (G % 8 == 0) ? (bx % 8) * (G / 8) + bx / 8 : bx; const int per = (G % 8 == 0) ? G / 8 : G;
    U = U_; if (G % 8 == 0) { x = v / per; j = v % per; Ux = (U + 7) / 8; } else { x = 0; j = v; Ux = U; } }
  DI int per() const { return (gridDim.x % 8 == 0) ? gridDim.x / 8 : gridDim.x; }
  DI int id(int i) const { const int t = j + i * per(); if (t >= Ux) return -1; const int g = x * Ux + t; return g < U ? g : -1; }
};


struct EpiQK { static constexpr bool STAGED = false;
  unsigned char* Q; unsigned char* Kt; const float* qg; const float* kg; const float* rope;
  DI void operator()(const f32x4 (&acc)[2][2][4][2], const Unit& u, int wr, int wc, int fr_, int fq_) const {
    int fr = fr_, fq = fq_; asm volatile("" : "+v"(fr), "+v"(fq));
    const int pm = u.i0, pn = u.i1;
    const int b = pm / 33, pt = pm % 33;
    const bool isq = pn < 4;
    if (isq && pt == 32) return;
    const int g = 4 * (pn & 3) + wc, hh = g >> 1, comp = g & 1;
    const float* gain = isq ? qg : kg;
    const int fq1 = fq >> 1, fq0 = fq & 1;
    const float qs = isq ? 1.4426950408889634f : 1.0f;
    const float* gp = gain + 32 * fq1 + 8 * fq0;
#pragma unroll
    for (int ai = 0; ai < 2; ++ai)
#pragma unroll
      for (int m = 0; m < 4; ++m) {
        const int pos = pt * 256 + 128 * ai + 64 * wr + 16 * m + fr;
        float ss = 0.f;
#pragma unroll
        for (int bj = 0; bj < 2; ++bj)
#pragma unroll
          for (int n = 0; n < 2; ++n) { const f32x4 v = acc[ai][bj][m][n]; ss += (v[0] * v[0] + v[1] * v[1]) + (v[2] * v[2] + v[3] * v[3]); }
        ss += __shfl_xor(ss, 16); ss += __shfl_xor(ss, 32);
        const float rstd = rsqrtf(ss * (1.0f / 64.0f) + EPS) * qs;
        const bool dorope = pos < SEQ;
        const int pp = fq1 ? (pos & 63) : ((pos >> 6) & 127);
        const float* rp = rope + (pp * 16 + 8 * fq0) * 2;
        u32x4 w;
#pragma unroll
        for (int bj = 0; bj < 2; ++bj) {
          const f32x4 g0 = *(const f32x4*)(gp + 4 * bj), g1 = *(const f32x4*)(gp + 16 + 4 * bj);
          f32x4 y0 = acc[ai][bj][m][0] * rstd * g0, y1 = acc[ai][bj][m][1] * rstd * g1;
          if (dorope) {
            const f32x4 cs0 = *(const f32x4*)(rp + (4 * bj) * 2), cs1 = *(const f32x4*)(rp + (4 * bj + 2) * 2);
            const f32x4 cc = {cs0[0], cs0[2], cs1[0], cs1[2]}, sn = {cs0[1], cs0[3], cs1[1], cs1[3]};
            const f32x4 r0 = y0 * cc - y1 * sn, r1 = y1 * cc + y0 * sn; y0 = r0; y1 = r1;
          }
          const unsigned p0 = pk4_fp8(y0[0], y0[1], y0[2], y0[3]), p1 = pk4_fp8(y1[0], y1[1], y1[2], y1[3]);
          if (bj == 0) { w.x = p0; w.z = p1; } else { w.y = p0; w.w = p1; }
        }
        if (isq) *(u32x4*)(Q + ((size_t)(((b * NH + hh) * 2 + comp) * SEQ + pos) * 64 + fq1 * 32 + fq0 * 16)) = w;
        else *(u32x4*)(Kt + ((size_t)((b * NH + hh) * NKT + (pos >> 6)) * 8192 + comp * 4096 + ((pos >> 5) & 1) * 2048 + fq0 * 1024 + fq1 * 512 + (pos & 31) * 16)) = w;
      }
  }
};
struct EpiVt { static constexpr bool STAGED = false;
  unsigned char* Vt;
  DI void operator()(const f32x4 (&acc)[2][2][4][2], const Unit& u, int wr, int wc, int fr_, int fq_) const {
    int fr = fr_, fq = fq_; asm volatile("" : "+v"(fr), "+v"(fq));
    const int pmv = u.i0, pn = u.i1;
    const int b = pn / 33, pt = pn % 33;
    const int tile = pt * 4 + wc, c = fq >> 1, hi = fq & 1;
#pragma unroll
    for (int ai = 0; ai < 2; ++ai)
#pragma unroll
      for (int m = 0; m < 4; ++m) {
        const int head = 2 * pmv + ai, v = 64 * wr + 16 * m + fr, vb = v >> 5, vv = v & 31;
        const f32x4 a0 = acc[ai][0][m][0], a1 = acc[ai][0][m][1], a2 = acc[ai][1][m][0], a3 = acc[ai][1][m][1];
        u32x4 w; w.x = pk4_fp8(16.f * a0[0], 16.f * a0[1], 16.f * a0[2], 16.f * a0[3]); w.y = pk4_fp8(16.f * a1[0], 16.f * a1[1], 16.f * a1[2], 16.f * a1[3]);
        w.z = pk4_fp8(16.f * a2[0], 16.f * a2[1], 16.f * a2[2], 16.f * a2[3]); w.w = pk4_fp8(16.f * a3[0], 16.f * a3[1], 16.f * a3[2], 16.f * a3[3]);
        *(u32x4*)(Vt + ((size_t)((b * NH + head) * NKT + tile) * 8192 + vb * 2048 + c * 1024 + hi * 512 + vv * 16)) = w;
      }
  }
};
template <bool RES_F32>
struct EpiResid { static constexpr bool STAGED = false;
  const float* resf; bf16_t* xr; const float* gate; float* rowss;
  DI void operator()(const f32x4 (&acc)[2][2][4][2], const Unit& u, int wr, int wc, int fr_, int fq_) const {
    int fr = fr_, fq = fq_; asm volatile("" : "+v"(fr), "+v"(fq));
    const int pm = u.i0, pn = u.i1, b = pm / 32;
    const int col0 = pn * 256 + wc * 32 + 8 * fq;
    f32x4 gv[2][2];
#pragma unroll
    for (int bj = 0; bj < 2; ++bj)
#pragma unroll
      for (int n = 0; n < 2; ++n) gv[bj][n] = *(const f32x4*)(gate + b * 6144 + col0 + bj * 128 + n * 4);
    u32x4 nx[2][2];
#define ER_LOAD(it_) do { const int row_ = pm * 256 + ((it_) >> 2) * 128 + wr * 64 + ((it_) & 3) * 16 + fr; const size_t off_ = (size_t)row_ * D + col0; \
      _Pragma("unroll") for (int bj = 0; bj < 2; ++bj) { \
        if (RES_F32) { nx[bj][0] = *(const u32x4*)(resf + off_ + bj * 128); nx[bj][1] = *(const u32x4*)(resf + off_ + bj * 128 + 4); } \
        else nx[bj][0] = *(const u32x4*)(xr + off_ + bj * 128); } } while (0)
    ER_LOAD(0);
#pragma unroll
    for (int it = 0; it < 8; ++it) { const int ai = it >> 2, m = it & 3;
        const int row = pm * 256 + ai * 128 + wr * 64 + m * 16 + fr;
        const size_t off = (size_t)row * D + col0;
        float ss = 0.f;
        u32x4 cu[2][2];
#pragma unroll
        for (int bj = 0; bj < 2; ++bj) { cu[bj][0] = nx[bj][0]; cu[bj][1] = nx[bj][1]; }
        if (it < 7) ER_LOAD(it + 1);
#pragma unroll
        for (int bj = 0; bj < 2; ++bj) {
          f32x4 r0, r1;
          if (RES_F32) { r0 = __builtin_bit_cast(f32x4, cu[bj][0]); r1 = __builtin_bit_cast(f32x4, cu[bj][1]); }
          else { const u32x4 w = cu[bj][0];
            r0 = (f32x4){__uint_as_float(w.x << 16), __uint_as_float(w.x & 0xffff0000u), __uint_as_float(w.y << 16), __uint_as_float(w.y & 0xffff0000u)};
            r1 = (f32x4){__uint_as_float(w.z << 16), __uint_as_float(w.z & 0xffff0000u), __uint_as_float(w.w << 16), __uint_as_float(w.w & 0xffff0000u)}; }
          const f32x4 o0 = r0 + gv[bj][0] * acc[ai][bj][m][0], o1 = r1 + gv[bj][1] * acc[ai][bj][m][1];
          u32x4 w; w.x = cvtpk(o0[0], o0[1]); w.y = cvtpk(o0[2], o0[3]); w.z = cvtpk(o1[0], o1[1]); w.w = cvtpk(o1[2], o1[3]);
          *(u32x4*)(xr + off + bj * 128) = w;
          ss += (o0[0] * o0[0] + o0[1] * o0[1]) + (o0[2] * o0[2] + o0[3] * o0[3]) + (o1[0] * o1[0] + o1[1] * o1[1]) + (o1[2] * o1[2] + o1[3] * o1[3]); }
        ss += __shfl_xor(ss, 16); ss += __shfl_xor(ss, 32);
        if (fq == 0) rowss[(size_t)row * 16 + 4 * pn + wc] = ss;
      }
#undef ER_LOAD
  }
};
struct EpiBf16 { static constexpr bool STAGED = false;
  bf16_t* O; int ldc; const float* scale; int colbase;
  DI void operator()(const f32x4 (&acc)[2][2][4][2], const Unit& u, int wr, int wc, int fr_, int fq_) const {
    int fr = fr_, fq = fq_; asm volatile("" : "+v"(fr), "+v"(fq));
    const int pm = u.i0, pn = u.i1;
    const int col0 = colbase + pn * 256 + wc * 32 + 8 * fq;
    f32x4 sv[2][2];
#pragma unroll
    for (int bj = 0; bj < 2; ++bj)
#pragma unroll
      for (int n = 0; n < 2; ++n) sv[bj][n] = scale ? *(const f32x4*)(scale + col0 + bj * 128 + 4 * n) : (f32x4){1.f, 1.f, 1.f, 1.f};
#pragma unroll
    for (int ai = 0; ai < 2; ++ai)
#pragma unroll
      for (int m = 0; m < 4; ++m) {
        bf16_t* rowp = O + (size_t)(pm * 256 + ai * 128 + wr * 64 + m * 16 + fr) * ldc + col0;
#pragma unroll
        for (int bj = 0; bj < 2; ++bj) { const f32x4 v0 = acc[ai][bj][m][0] * sv[bj][0], v1 = acc[ai][bj][m][1] * sv[bj][1];
          u32x4 w; w.x = cvtpk(v0[0], v0[1]); w.y = cvtpk(v0[2], v0[3]); w.z = cvtpk(v1[0], v1[1]); w.w = cvtpk(v1[2], v1[3]);
          *(u32x4*)(rowp + bj * 128) = w; }
      }
  }
};
struct EpiAct { static constexpr bool STAGED = false;
  bf16_t* act;
  DI void operator()(const f32x4 (&acc)[2][2][4][2], const Unit& u, int wr, int wc, int fr_, int fq_) const {
    int fr = fr_, fq = fq_; asm volatile("" : "+v"(fr), "+v"(fq));
    const int slot0 = u.i0, nvalid = u.i1, pn = u.i2;
    const int col0 = pn * 128 + wc * 32 + 8 * fq;
#pragma unroll
    for (int ai = 0; ai < 2; ++ai)
#pragma unroll
      for (int m = 0; m < 4; ++m) {
        const int r = ai * 128 + wr * 64 + m * 16 + fr;
        float o[8];
#pragma unroll
        for (int n = 0; n < 2; ++n)
#pragma unroll
          for (int i = 0; i < 4; ++i) { const float g = acc[ai][0][m][n][i], uu = acc[ai][1][m][n][i]; o[4 * n + i] = silu_f(g) * uu; }
        if (r < nvalid) { u32x2 w; w.x = pk4_fp8(o[0], o[1], o[2], o[3]); w.y = pk4_fp8(o[4], o[5], o[6], o[7]);
          *(u32x2*)((unsigned char*)act + (size_t)(slot0 + r) * DE + col0) = w; }
      }
  }
};
struct EpiY { static constexpr bool STAGED = false;
  unsigned char* y; const float* gl;
  DI void operator()(const f32x4 (&acc)[2][2][4][2], const Unit& u, int wr, int wc, int fr_, int fq_) const {
    int fr = fr_, fq = fq_; asm volatile("" : "+v"(fr), "+v"(fq));
    const int slot0 = u.i0, nvalid = u.i1, pn = u.i2; const float* g = gl + u.i3;
    const int col0 = pn * 256 + wc * 32 + 8 * fq;
    float gt[2][4];
#pragma unroll
    for (int ai = 0; ai < 2; ++ai)
#pragma unroll
      for (int m = 0; m < 4; ++m) { const int r = ai * 128 + wr * 64 + m * 16 + fr; gt[ai][m] = 16.0f * g[r < nvalid ? r : 0]; }
#pragma unroll
    for (int ai = 0; ai < 2; ++ai)
#pragma unroll
      for (int m = 0; m < 4; ++m) {
        const int r = ai * 128 + wr * 64 + m * 16 + fr;
        if (r < nvalid) {
          unsigned char* rowp = y + (size_t)(slot0 + r) * D + col0;
#pragma unroll
          for (int bj = 0; bj < 2; ++bj) { const f32x4 v0 = acc[ai][bj][m][0] * gt[ai][m], v1 = acc[ai][bj][m][1] * gt[ai][m];
            u32x2 w; w.x = pk4_fp8(v0[0], v0[1], v0[2], v0[3]); w.y = pk4_fp8(v1[0], v1[1], v1[2], v1[3]);
            *(u32x2*)(rowp + bj * 128) = w; }
        }
      }
  }
};

struct SchedGrid {
  const char* A0; const char* B0; size_t astep, bstep; int nM, nN, acol; Deal dl;
  DI void init(const void* A, const void* B, int lda, int ldb, int nM_, int nN_, int acol_ = 0) { A0 = (const char*)A; B0 = (const char*)B; astep = (size_t)256 * lda; bstep = (size_t)256 * ldb; nM = nM_; nN = nN_; acol = acol_; dl.init(nM_ * nN_); }
  DI bool next(int i, Unit& u) const { const int id = dl.id(i); if (id < 0) return false;
    const int grp = 8 * nN, gi = id / grp, fm = gi * 8, gsz = (nM - fm) < 8 ? (nM - fm) : 8; const int pm = fm + (id % grp) % gsz, pn = (id % grp) / gsz;
    u.A = A0 + pm * astep + pn * acol; u.B = B0 + pn * bstep; u.i0 = pm; u.i1 = pn; u.i2 = 0; u.i3 = 0; return true; }
  DI int arow(const Unit&, int r) const { return r; }
};
constexpr int QKV_GEMM_PER_XCD = 25;
struct SchedQKV {
  const char* H; const char* Wqk; const char* Wv; Deal dl;
  DI void init(const void* hcat, const void* wqk, const void* wv) { H = (const char*)hcat; Wqk = (const char*)wqk; Wv = (const char*)wv; dl.init(1584); }
  DI bool next(int i, Unit& u) const { if (dl.j >= QKV_GEMM_PER_XCD) return false; const int t = dl.j + i * QKV_GEMM_PER_XCD; if (t >= 198) return false;
    if (t < 132) { const int id = dl.x * 132 + t; const int gi = id >> 6, fm = gi * 8, gsz = (132 - fm) < 8 ? (132 - fm) : 8; const int pm = fm + (id & 63) % gsz, pn = (id & 63) / gsz;
      u.A = H + (size_t)pm * 256 * 1024; u.B = Wqk + (size_t)pn * 256 * 1024; u.i0 = pm; u.i1 = pn; u.i2 = 0; u.i3 = 0; }
    else { const int id = dl.x * 66 + (t - 132); const int pm = id & 3, pn = id >> 2;
      u.A = Wv + (size_t)pm * 256 * 1024; u.B = H + (size_t)pn * 256 * 1024; u.i0 = pm; u.i1 = pn; u.i2 = 1; u.i3 = 0; }
    return true; }
  DI int arow(const Unit&, int r) const { return r; }
  DI bool bkind(const Unit& u) const { return u.i2 != 0; }
};
struct SchedFold {
  const char* A0; const char* B0; Deal dl;
  DI void init(const void* wpo, const void* wpg) { A0 = (const char*)wpo; B0 = (const char*)wpg; dl.init(1584); }
  DI bool next(int i, Unit& u) const { if (i > 0 || dl.j < QKV_GEMM_PER_XCD) return false;
    const int id = dl.x * (dl.per() - QKV_GEMM_PER_XCD) + (dl.j - QKV_GEMM_PER_XCD); if (id >= 16) return false;
    const int pm = id & 3, g = id >> 2;
    u.A = A0 + (size_t)pm * 256 * 2048 + g * 512; u.B = B0 + (size_t)g * 256 * 512; u.i0 = pm; u.i1 = g; u.i2 = 0; u.i3 = 0; return true; }
  DI int arow(const Unit&, int r) const { return r; }
};
struct EpiQKV { static constexpr bool STAGED = false; EpiQK q; EpiVt v;
  DI void operator()(const f32x4 (&acc)[2][2][4][2], const Unit& u, int wr, int wc, int fr, int fq) const { if (u.i2 == 0) q(acc, u, wr, wc, fr, fq); else v(acc, u, wr, wc, fr, fq); }
};
template <bool GA, int WSTEP_E, int WSTEP_PN, int LDA>
struct SchedMoe {
  const LAS int* T; const char* A0; const char* W0; const int* tok; Deal dl;
  DI bool next(int i, Unit& u) const { const int id = dl.id(i); if (id < 0) return false;
    const int tile = id >> 2, pn = id & 3; const int e = T[128 + tile];
    const int j = tile - T[e], cnt = T[66 + e], slot0 = T[33 + e] + 256 * j, nv = cnt - 256 * j;
    u.A = GA ? A0 : A0 + (size_t)slot0 * LDA; u.B = W0 + (size_t)e * WSTEP_E + pn * WSTEP_PN;
    u.i0 = slot0; u.i1 = nv < 256 ? nv : 256; u.i2 = pn; u.i3 = e * 32768 + 256 * j; return true; }
  DI int arow(const Unit& u, int r) const { return r < u.i1 ? tok[u.i3 + r] : 0; }
};

DI void phase_mods(const Params& p, LAS unsigned char* lds) {
  float* sm = (float*)(WSP + WS_SMALL);
  LAS float* sc = (LAS float*)lds;
  LAS float* red = sc + 5 * 1024;
  const int tid = opaque_tid();
  for (int i = tid; i < 5 * 1024; i += 512) { const float v = (i < 4096) ? p.c[i] : p.c_ctx[i - 4096]; sc[i] = silu_f(v); }
  __syncthreads();
  for (int it = blockIdx.x; it < 192; it += gridDim.x) {
    const int l = it / 96, col = (it % 96) * 64 + (tid & 63), ks = tid >> 6;
    const float* w = p.ada_w + (size_t)l * D * 6144 + col;
    float a0 = 0.f, a1 = 0.f, a2 = 0.f, a3 = 0.f, a4 = 0.f;
    for (int k0 = ks * 128; k0 < ks * 128 + 128; k0 += 32) {
      float wv[32];
#pragma unroll
      for (int u = 0; u < 32; ++u) wv[u] = w[(size_t)(k0 + u) * 6144];
#pragma unroll
      for (int u = 0; u < 32; ++u) { const int k = k0 + u; a0 += sc[k] * wv[u]; a1 += sc[1024 + k] * wv[u]; a2 += sc[2048 + k] * wv[u]; a3 += sc[3072 + k] * wv[u]; a4 += sc[4096 + k] * wv[u]; } }
    LAS float* r = red + (ks * 64 + (tid & 63)) * 5; r[0] = a0; r[1] = a1; r[2] = a2; r[3] = a3; r[4] = a4;
    __syncthreads();
    if (tid < 320) { const int cc = tid & 63, bb = tid >> 6; float s = 0.f;
#pragma unroll
      for (int k = 0; k < 8; ++k) s += red[(k * 64 + cc) * 5 + bb];
      const int c2 = (it % 96) * 64 + cc; s += p.ada_b[l * 6144 + c2];
      if (bb < 4) sm[SM_MOD + (l * 4 + bb) * 6144 + c2] = s; else if (l == 0 && c2 < 2048) sm[SM_MODC + c2] = s; }
    __syncthreads();
  }
  if (blockIdx.x == gridDim.x - 1) {
    if (tid < 64) {
      float a = p.lq1[tid] * p.lk1[tid], b = p.lq2[tid] * p.lk2[tid]; a = wave_sum(a); b = wave_sum(b);
      float mq = fabsf(p.qg[tid]), mk = fabsf(p.kg[tid]);
#pragma unroll
      for (int o = 1; o < 64; o <<= 1) { mq = fmaxf(mq, __shfl_xor(mq, o)); mk = fmaxf(mk, __shfl_xor(mk, o)); }
      if (tid == 0) { sm[SM_SCAL + 0] = __expf(a) - __expf(b) + 0.2f; sm[SM_SCAL + 1] = -(8.0f * mq * mk * LOG2E + 0.01f); }
    }
    for (int i = tid; i < 2048; i += 512) { const int pos = i >> 4, f = i & 15; const float inv = powf(10000.0f, -(float)f / 16.0f); const float ang = (float)pos * inv; float s, c; sincosf(ang, &s, &c);
      sm[SM_ROPE + i * 2] = c; sm[SM_ROPE + i * 2 + 1] = s; }
  }
}
template <bool F8>
DI void transpose_item_t(const float* W, int ldn, int K, void* WTv, int k0, int n0, int drow0, LAS float* scr, int lane, const float* ksc = nullptr) {
  f32x4 v[8];
#pragma unroll
  for (int i = 0; i < 8; ++i) v[i] = *(const f32x4*)(W + (size_t)(k0 + 8 * i + (lane >> 3)) * ldn + n0 + 4 * (lane & 7));
#pragma unroll
  for (int i = 0; i < 8; ++i) { LAS float* d = scr + (8 * i + (lane >> 3)) * 33 + 4 * (lane & 7); d[0] = v[i][0]; d[1] = v[i][1]; d[2] = v[i][2]; d[3] = v[i][3]; }
  asm volatile("s_waitcnt lgkmcnt(0)" ::: "memory");
  const int c = lane & 7;
#pragma unroll
  for (int j = 0; j < 4; ++j) { const int n = (lane >> 3) + 8 * j; const LAS float* s = scr + (8 * c) * 33 + n;
    if constexpr (F8) { u32x2 o; o.x = pk4_fp8(32.f * s[0 * 33], 32.f * s[1 * 33], 32.f * s[2 * 33], 32.f * s[3 * 33]); o.y = pk4_fp8(32.f * s[4 * 33], 32.f * s[5 * 33], 32.f * s[6 * 33], 32.f * s[7 * 33]);
      *(u32x2*)((unsigned char*)WTv + (size_t)(drow0 + n) * K + k0 + 8 * c) = o; }
    else { f32x4 m0 = {1.f, 1.f, 1.f, 1.f}, m1 = m0; if (ksc) { m0 = *(const f32x4*)(ksc + k0 + 8 * c); m1 = *(const f32x4*)(ksc + k0 + 8 * c + 4); }
      u32x4 o; o.x = cvtpk(s[0 * 33] * m0[0], s[1 * 33] * m0[1]); o.y = cvtpk(s[2 * 33] * m0[2], s[3 * 33] * m0[3]); o.z = cvtpk(s[4 * 33] * m1[0], s[5 * 33] * m1[1]); o.w = cvtpk(s[6 * 33] * m1[2], s[7 * 33] * m1[3]);
      *(u32x4*)((bf16_t*)WTv + (size_t)(drow0 + n) * K + k0 + 8 * c) = o; } }
  asm volatile("s_waitcnt lgkmcnt(0)" ::: "memory");
}
DI void transpose_item(const float* W, int ldn, int K, bf16_t* WT, int k0, int n0, int drow0, LAS float* scr, int lane) { transpose_item_t<false>(W, ldn, K, WT, k0, n0, drow0, scr, lane); }
DI void phase_weights_small(const Params& p, LAS unsigned char* lds) {
  const int tid = opaque_tid(), lane = tid & 63, wave = tid >> 6;
  LAS float* scr = (LAS float*)(lds + wave * 16384);
  const int gw = blockIdx.x * 8 + wave, NGW = gridDim.x * 8;
  unsigned char* ws = WSP;
  constexpr int I_QK = 16 * 64, I_V = 16 * 32, I_SQ = 16 * 32, I_PG = 4 * 4 * 8, I_R = 16 * 1;
  constexpr int I_SMALL = I_QK + I_V + 3 * I_SQ + I_PG + I_R;
  for (int it = gw; it < I_SMALL; it += NGW) {
    int r = it;
    if (r < I_QK) { const int kb = r / 64, nb = r % 64; transpose_item_t<true>(p.w_in, 3072, 1024, ws + WS_WQK, 64 * kb, 32 * nb, 32 * nb, scr, lane); continue; } r -= I_QK;
    if (r < I_V) { const int kb = r / 32, nb = r % 32; transpose_item_t<true>(p.w_in + 2048, 3072, 1024, ws + WS_WV, 64 * kb, 32 * nb, 32 * nb, scr, lane); continue; } r -= I_V;
    if (r < I_SQ) { const int kb = r / 32, nb = r % 32; transpose_item(p.w_out, 1024, 1024, (bf16_t*)(ws + WS_WO), 64 * kb, 32 * nb, 32 * nb, scr, lane); continue; } r -= I_SQ;
    if (r < I_SQ) { const int kb = r / 32, nb = r % 32; transpose_item(p.pw_in, 1024, 1024, (bf16_t*)(ws + WS_WPI), 64 * kb, 32 * nb, 32 * nb, scr, lane); continue; } r -= I_SQ;
    if (r < I_SQ) { const int kb = r / 32, nb = r % 32; transpose_item_t<false>(p.pw_out, 1024, 1024, ws + WS_WPO, 64 * kb, 32 * nb, 32 * nb, scr, lane, p.pscale); continue; } r -= I_SQ;
    if (r < I_PG) { const float* src = p.pw_g + (size_t)r * 2048; bf16_t* dst = (bf16_t*)(ws + WS_WPG) + (size_t)r * 2048;
#pragma unroll
      for (int q = 0; q < 8; ++q) { const f32x4 v = *(const f32x4*)(src + q * 256 + lane * 4); u32x2 o; o.x = cvtpk(v[0], v[1]); o.y = cvtpk(v[2], v[3]); *(u32x2*)(dst + q * 256 + lane * 4) = o; }
      continue; } r -= I_PG;
    transpose_item(p.rw, 32, 1024, (bf16_t*)(ws + WS_WR), 64 * r, 0, 0, scr, lane);
  }
}
constexpr int LDS_TAB_OFF = 131072;
DI void phase_weights_moe(const Params& p, LAS unsigned char* lds) {
  const int tid = opaque_tid(), lane = tid & 63, wave = tid >> 6;
  LAS float* scr = (LAS float*)(lds + wave * 16384);
  volatile LAS unsigned* qs = (volatile LAS unsigned*)(lds + LDS_TAB_OFF + 1024);
  unsigned char* ws = WSP; unsigned* ctr = (unsigned*)(ws + WS_CTL) + CW_WQ;
  constexpr int I_GU = 2 * 32 * 16 * 16  , I_D = 2 * 32 * 8 * 32;
  constexpr int NIT = 2 * I_GU + I_D, CHW = 32;
  static_assert(NIT % CHW == 0, "whole chunks");
  for (int it = 0;; ++it) {
    if (tid == 0) qs[it & 1] = __hip_atomic_fetch_add(ctr, 1u, __ATOMIC_RELAXED, __HIP_MEMORY_SCOPE_AGENT);
    __syncthreads();
    const unsigned c0 = (unsigned)__builtin_amdgcn_readfirstlane((int)qs[it & 1]);
    if ((int)c0 * CHW >= NIT) break;
    for (int k = 0; k < 4; ++k) { int r = (int)c0 * CHW + wave * 4 + k;
      if (r < 2 * I_GU) { const int up = r / I_GU; r %= I_GU; const int le = r / 256, q = r % 256, kb = q / 16, nb = q % 16;
        const float* src = (up ? p.wu : p.wg) + (size_t)le * 1024 * 512; const int n0 = 32 * nb;
        transpose_item_t<true>(src, 512, 1024, ws + WS_WGU + (size_t)le * 1024 * 1024, 64 * kb, n0, 256 * (n0 >> 7) + 128 * up + (n0 & 127), scr, lane); continue; } r -= 2 * I_GU;
      { const int le = r / 256, q = r % 256, kb = q / 32, nb = q % 32;
        transpose_item_t<true>(p.wd + (size_t)le * 512 * 1024, 1024, 512, ws + WS_WD + (size_t)le * 1024 * 512, 64 * kb, 32 * nb, 32 * nb, scr, lane); } }
  }
}
DI void norm_mod_row(const float* xr, const float* g, const float* shift, const float* scale, unsigned char* orow, int lane) {
  f32x4 v[4]; float s = 0.f;
#pragma unroll
  for (int j = 0; j < 4; ++j) { v[j] = *(const f32x4*)(xr + 4 * lane + 256 * j); s += (v[j][0] * v[j][0] + v[j][1] * v[j][1]) + (v[j][2] * v[j][2] + v[j][3] * v[j][3]); }
  const float rstd = rsqrtf(wave_sum(s) * (1.f / D) + EPS);
#pragma unroll
  for (int j = 0; j < 4; ++j) { const int c = 4 * lane + 256 * j; const f32x4 gg = *(const f32x4*)(g + c), sh = *(const f32x4*)(shift + c), sc = *(const f32x4*)(scale + c);
    const f32x4 y = v[j] * rstd * gg * (sc + 1.0f) + sh; *(unsigned*)(orow + c) = pk4_fp8(y[0], y[1], y[2], y[3]); }
}
DI void phase_hcat(const Params& p) {
  const float* sm = (const float*)(WSP + WS_SMALL); unsigned char* hcat = WSP + WS_R0;
  const int tid = opaque_tid(), lane = tid & 63, gw = blockIdx.x * 8 + (tid >> 6), NGW = gridDim.x * 8;
  for (int r = gw; r < NROWS; r += NGW) { const int b = r / KV, t = r % KV;
    if (t < SEQ) norm_mod_row(p.x + (size_t)(b * SEQ + t) * D, p.n1g, sm + SM_MOD + b * 6144, sm + SM_MOD + b * 6144 + 1024, hcat + (size_t)r * D, lane);
    else norm_mod_row(p.ctx + (size_t)(b * CTXL + t - SEQ) * D, p.n1g, sm + SM_MODC, sm + SM_MODC + 1024, hcat + (size_t)r * D, lane); }
}
namespace att {
constexpr int SLOT = 8192, LDS_K = 0, LDS_V = 3 * SLOT, NT = NKT;
typedef const LAS char* lptr;
DI void glds16(const void* gsrc, unsigned lds_dst) { unsigned keep;
  asm volatile("s_mov_b32 %0, m0\n\ts_mov_b32 m0, %2\n\ts_nop 0\n\tglobal_load_lds_dwordx4 %1, off\n\ts_mov_b32 m0, %0" : "=&s"(keep) : "v"(gsrc), "s"(lds_dst) : "memory"); }
DI u32x4 ldsrdu(lptr p) { return *(const LAS u32x4*)p; }
DI float max3f(float a, float b, float c) { float d; asm("v_max3_f32 %0, %1, %2, %3" : "=v"(d) : "v"(a), "v"(b), "v"(c)); return d; }
DI int pk4s(float a, float b, float c, float d, float sc) { int r;
  asm("v_cvt_scalef32_pk_fp8_f32 %0, %1, %2, %3" : "=v"(r) : "v"(a), "v"(b), "v"(sc));
  asm("v_cvt_scalef32_pk_fp8_f32 %0, %1, %2, %3 op_sel:[0,0,0,1]" : "+v"(r) : "v"(c), "v"(d), "v"(sc)); return r; }
#define AT_WAIT_BAR(N) asm volatile("s_waitcnt vmcnt(" #N ") lgkmcnt(0)\n\ts_barrier" ::: "memory")
#define AT_SBAR() __builtin_amdgcn_sched_barrier(0)
#define AT_EX(v) __builtin_amdgcn_exp2f(v)
#define AT_CAT2(lo, hi) __builtin_bit_cast(v8i_t, __builtin_shufflevector((lo), (hi), 0, 1, 2, 3, 4, 5, 6, 7))
#define AT_MFMA8(acc, va, pb, sa, sb) asm volatile("v_mfma_scale_f32_32x32x64_f8f6f4 %0, %1, %2, %0, %3, %4 op_sel_hi:[0,0,0]" : "+v"(acc) : "v"(va), "v"(pb), "v"(sa), "v"(sb))
#define AT_QK8(c, ka, qb_) asm volatile("v_mfma_scale_f32_32x32x64_f8f6f4 %0, %1, %2, 0, %3, %4 op_sel_hi:[0,0,0]" : "=&v"(c) : "v"(ka), "v"(qb_), "v"(sck), "v"(scq))

DI void attn_unit(const char* Kt, const char* Vt, const unsigned char* Q, bf16_t* AO, const float* subg, LAS unsigned char* lds, int b, int h, int qb, float lam, int smul, int sadd) {
  const int tid = opaque_tid(), lane = tid & 63, r32 = lane & 31, hi = lane >> 5;
  const int wid = __builtin_amdgcn_readfirstlane(tid >> 6), comp = wid >> 2, wq = wid & 3;
  const int q0 = qb * 128 + wq * 32;
  const char* ksrc = Kt + (size_t)(b * NH + h) * NT * 8192 + wid * 1024 + lane * 16;
  const char* vsrc = Vt + (size_t)(b * NH + h) * NT * 8192 + wid * 1024 + lane * 16;
  const unsigned lds0 = (unsigned)(size_t)lds;
  const unsigned kdst = lds0 + LDS_K + wid * 1024, vdst = lds0 + LDS_V + wid * 1024;
#define DMA_K(t, slot) glds16(ksrc + (size_t)(t) * 8192, (unsigned)__builtin_amdgcn_readfirstlane(kdst + (slot)))
#define DMA_V(t, slot) glds16(vsrc + (size_t)(t) * 8192, (unsigned)__builtin_amdgcn_readfirstlane(vdst + (slot)))
  const lptr kp0 = (lptr)lds + LDS_K + comp * 4096 + hi * 512 + r32 * 16;
  const lptr vp0 = (lptr)lds + LDS_V + hi * 512 + r32 * 16;
  DMA_K(0, 0); DMA_V(0, 0); DMA_K(1, SLOT);
  v8i_t q8;
  { const unsigned char* Qw = Q + (size_t)(((b * NH + h) * 2 + comp) * SEQ + q0 + r32) * 64 + hi * 32;
    q8 = AT_CAT2(*(const u32x4*)Qw, *(const u32x4*)(Qw + 16)); }
  DMA_K(2, 2 * SLOT);
  f32x16 o[4], ol;
  v8i_t ones8 = {0x38383838, 0x38383838, 0x38383838, 0x38383838, 0x38383838, 0x38383838, 0x38383838, 0x38383838};
  asm volatile("" : "+v"(ones8));
#pragma unroll
  for (int r = 0; r < 16; ++r) { o[0][r] = 0.f; o[1][r] = 0.f; o[2][r] = 0.f; o[3][r] = 0.f; ol[r] = 0.f; }
  v8i_t kf[2]; u32x4 vlo[4], vhi[4];
  f32x16 pA0, pA1, pB0, pB1; v8i_t pq;
  int psc = 127; float pscf = 1.0f; int sca = 123, sck = 127, scq = 124, sc1 = 127;
  asm volatile("" : "+v"(sca), "+v"(sck), "+v"(scq), "+v"(sc1));
#define SETSC(smax) do { psc = (int)__builtin_floorf(smax) + 120; pscf = __builtin_bit_cast(float, ((psc ^ smul) + sadd) << 23); } while (0)
#define KLD(kp_, kb) AT_CAT2(ldsrdu((kp_) + (kb) * 2048), ldsrdu((kp_) + (kb) * 2048 + 1024))
  int sl_prev = 0, sl_cur = 0, sl_next = SLOT;
#define ROT() do { sl_prev = sl_cur; sl_cur = sl_next; sl_next = (sl_next == 2 * SLOT) ? 0 : sl_next + SLOT; } while (0)
  AT_WAIT_BAR(3);
  { kf[0] = KLD(kp0, 0); kf[1] = KLD(kp0, 1);
    AT_QK8(pA0, kf[0], q8); AT_QK8(pA1, kf[1], q8);
    asm volatile("s_nop 15\n\ts_nop 15\n\ts_nop 15\n\ts_nop 15\n\ts_nop 15\n\ts_nop 15\n\ts_nop 15\n\ts_nop 15\n\ts_nop 15" : "+v"(pA0), "+v"(pA1));
    float smx = max3f(pA0[0], pA0[1], pA0[2]);
#pragma unroll
    for (int r = 3; r < 15; r += 2) smx = max3f(smx, pA0[r], pA0[r + 1]);
    smx = __builtin_fmaxf(smx, pA0[15]);
#pragma unroll
    for (int r = 0; r < 16; r += 2) smx = max3f(smx, pA1[r], pA1[r + 1]);
    SETSC(smx);
#pragma unroll
    for (int r = 0; r < 16; ++r) { pA0[r] = AT_EX(pA0[r]); pA1[r] = AT_EX(pA1[r]); } }
  AT_WAIT_BAR(0);
  DMA_K(3, 0); DMA_V(1, SLOT);
  ROT();
  { const lptr kp = kp0 + sl_cur; kf[0] = KLD(kp, 0); kf[1] = KLD(kp, 1); }
  AT_WAIT_BAR(2);
#define PVAL(P0, P1, j) ((j) < 16 ? P0[(j) & 15] : P1[(j) & 15])
#define EXP4(CX, B0) do { \
    smx_ = max3f(smx_, CX[(B0) + 0], CX[(B0) + 1]); smx_ = max3f(smx_, CX[(B0) + 2], CX[(B0) + 3]); \
    { float e0_ = AT_EX(CX[(B0) + 0]), e1_ = AT_EX(CX[(B0) + 1]), e2_ = AT_EX(CX[(B0) + 2]), e3_ = AT_EX(CX[(B0) + 3]); \
      asm volatile("" : "+v"(smx_), "+v"(e0_), "+v"(e1_), "+v"(e2_), "+v"(e3_)); \
      CX[(B0) + 0] = e0_; CX[(B0) + 1] = e1_; CX[(B0) + 2] = e2_; CX[(B0) + 3] = e3_; } } while (0)
#define EXP8(CX, B0) do { EXP4(CX, B0); EXP4(CX, (B0) + 4); } while (0)
#define GAPA(i, C0, C1, P0, P1) do { \
    if ((i) & 1) vhi[(i) >> 1] = ldsrdu(vp_ + ((i) >> 1) * 2048 + 1024); else vlo[(i) >> 1] = ldsrdu(vp_ + ((i) >> 1) * 2048); \
    if ((i) == 0) { AT_QK8(C0, kf[0], q8); } else if ((i) == 4) { AT_QK8(C1, kf[1], q8); } \
    { int w_ = pk4s(PVAL(P0, P1, 4 * (i)), PVAL(P0, P1, 4 * (i) + 1), PVAL(P0, P1, 4 * (i) + 2), PVAL(P0, P1, 4 * (i) + 3), pscf); \
      asm volatile("" : "+v"(w_)); pq[i] = w_; } \
    if ((i) == 6) { EXP4(C0, 0); } else if ((i) == 7) { EXP4(C0, 4); } \
    AT_SBAR(); } while (0)
#define GAPB(g, C0, C1, GL) do { \
    { const v8i_t va_ = AT_CAT2(vlo[g], vhi[g]); AT_MFMA8(o[g], va_, pq, sca, psc); } \
    if ((g) == 3) AT_MFMA8(ol, ones8, pq, sc1, psc); \
    if ((g) == 0) { EXP8(C0, 8); } else if ((g) == 1) { EXP8(C1, 0); } else if ((g) == 2) { EXP8(C1, 8); } \
    if ((GL) && (g) < 2) kf[g] = KLD(kn_, g); \
    AT_SBAR(); } while (0)
#define STEP(C0, C1, P0, P1, t, GK, GV, GL) do { AT_SBAR(); \
    const lptr vp_ = vp0 + sl_prev; const lptr kn_ = kp0 + sl_next; float smx_ = -3.0e38f; \
    GAPA(0, C0, C1, P0, P1); GAPA(1, C0, C1, P0, P1); GAPA(2, C0, C1, P0, P1); GAPA(3, C0, C1, P0, P1); \
    GAPA(4, C0, C1, P0, P1); GAPA(5, C0, C1, P0, P1); GAPA(6, C0, C1, P0, P1); GAPA(7, C0, C1, P0, P1); \
    if (GK) { DMA_K((t) + 3, sl_cur); } if (GV) { DMA_V((t) + 1, sl_next); } \
    AT_SBAR(); \
    GAPB(0, C0, C1, GL); GAPB(1, C0, C1, GL); GAPB(2, C0, C1, GL); GAPB(3, C0, C1, GL); \
    SETSC(smx_); \
  } while (0)
#define ENDW(tt) do { if ((tt) + 3 < NT) { AT_WAIT_BAR(2); } else if ((tt) + 2 < NT) { AT_WAIT_BAR(1); } else { AT_WAIT_BAR(0); } } while (0)
  int t = 1;
  for (; t + 5 < NT; t += 2) {
    STEP(pB0, pB1, pA0, pA1, t, true, true, true);     AT_WAIT_BAR(2); ROT();
    STEP(pA0, pA1, pB0, pB1, t + 1, true, true, true); AT_WAIT_BAR(2); ROT();
  }
  for (; t + 1 < NT; t += 2) {
    STEP(pB0, pB1, pA0, pA1, t, (t + 3 < NT), (t + 1 < NT), (t + 1 < NT));         ENDW(t);     ROT();
    STEP(pA0, pA1, pB0, pB1, t + 1, (t + 4 < NT), (t + 2 < NT), (t + 2 < NT));     ENDW(t + 1); ROT();
  }
  STEP(pB0, pB1, pA0, pA1, NT - 1, false, false, false);
  {
#pragma unroll
    for (int i = 0; i < 4; ++i) { pq[i] = pk4s(pB0[4 * i], pB0[4 * i + 1], pB0[4 * i + 2], pB0[4 * i + 3], pscf); pq[4 + i] = pk4s(pB1[4 * i], pB1[4 * i + 1], pB1[4 * i + 2], pB1[4 * i + 3], pscf); }
    const lptr vp = vp0 + sl_cur;
    asm volatile("s_nop 1" : "+v"(pq));
#pragma unroll
    for (int vb = 0; vb < 4; ++vb) { const v8i_t va_ = AT_CAT2(ldsrdu(vp + vb * 2048), ldsrdu(vp + vb * 2048 + 1024)); AT_MFMA8(o[vb], va_, pq, sca, psc); }
    AT_MFMA8(ol, ones8, pq, sc1, psc);
    asm volatile("s_nop 15\n\ts_nop 15\n\ts_nop 15\n\ts_nop 15\n\ts_nop 15\n\ts_nop 15" : "+v"(o[0]), "+v"(o[1]), "+v"(o[2]), "+v"(o[3]), "+v"(ol) :: "memory"); }
  const float l_reg = ol[0];
  AT_WAIT_BAR(0);
  LAS float* ex = (LAS float*)lds + wq * 4096;
  if (comp == 1) { const float f = lam / l_reg;
#pragma unroll
    for (int vb = 0; vb < 4; ++vb)
#pragma unroll
      for (int r = 0; r < 16; ++r) ex[(vb * 16 + r) * 64 + lane] = o[vb][r] * f; }
  AT_WAIT_BAR(0);
  if (comp == 0) { const float f = 1.0f / l_reg; float ss = 0.f;
#pragma unroll
    for (int vb = 0; vb < 4; ++vb)
#pragma unroll
      for (int r = 0; r < 16; ++r) { const float v = o[vb][r] * f - ex[(vb * 16 + r) * 64 + lane]; o[vb][r] = v; ss += v * v; }
    ss += __shfl_xor(ss, 32);
    const float rstd = rsqrtf(ss * (1.0f / 128.0f) + EPS) * 0.8f;
    LAS unsigned char* stg = lds + 65536 + wq * 8704;
#pragma unroll
    for (int vb = 0; vb < 4; ++vb)
#pragma unroll
      for (int gq = 0; gq < 4; ++gq) { const int v0 = 32 * vb + 8 * gq + 4 * hi; const f32x4 sg = *(const f32x4*)(subg + v0);
        u32x2 w; w.x = cvtpk(o[vb][4 * gq] * rstd * sg[0], o[vb][4 * gq + 1] * rstd * sg[1]); w.y = cvtpk(o[vb][4 * gq + 2] * rstd * sg[2], o[vb][4 * gq + 3] * rstd * sg[3]);
        *(LAS u32x2*)(stg + r32 * 272 + v0 * 2) = w; }
    asm volatile("s_waitcnt lgkmcnt(0)" ::: "memory");
    bf16_t* orow = AO + (size_t)(b * SEQ + q0) * D + h * 128;
#pragma unroll
    for (int i = 0; i < 8; ++i) { const int row = i * 4 + (lane >> 4), ch = lane & 15; const u32x4 v = *(const LAS u32x4*)(stg + row * 272 + ch * 16);
      *(u32x4*)(orow + (size_t)row * D + ch * 8) = v; }
  }
  AT_WAIT_BAR(0);
#undef DMA_K
#undef DMA_V
#undef ROT
#undef PVAL
#undef GAPA
#undef GAPB
#undef EXP4
#undef EXP8
#undef STEP
#undef ENDW
#undef SETSC
#undef KLD
}
}
DI void phase_attn(const Params& p, LAS unsigned char* lds) {
  const float* sm = (const float*)(WSP + WS_SMALL);
  const char* Kt = (const char*)(WSP + WS_R2); const char* Vt = (const char*)(WSP + WS_R3); const unsigned char* Q = WSP + WS_R1; bf16_t* AO = (bf16_t*)(WSP + WS_R0);
  const float lam = sm[SM_SCAL + 0];
  float one = 1.0f, four = 4.0f; asm volatile("" : "+v"(one), "+v"(four));
  const int tst = __builtin_amdgcn_readfirstlane(att::pk4s(one, one, one, one, four) & 0xff);
  const int smul = (tst == 0x28) ? 0 : 0xff, sadd = (tst == 0x28) ? 0 : -1;
  const int G = gridDim.x, bx = blockIdx.x; const int vcu = (G % 8 == 0) ? (bx % 8) * (G / 8) + bx / 8 : bx;
  for (int unit = vcu; unit < 2048; unit += G) { const int bh = unit >> 6, qb = unit & 63;
    att::attn_unit(Kt, Vt, Q, AO, p.subg, lds, bh >> 3, bh & 7, qb, lam, smul, sadd); }
}

DI void phase_router(const Params& p, LAS unsigned char* lds, int layer) {
  const float* sm = (const float*)(WSP + WS_SMALL);
  const bf16_t* X = (const bf16_t*)(WSP + WS_XR); bf16_t* h2 = (bf16_t*)(WSP + WS_R1); const bf16_t* Wr = (const bf16_t*)(WSP + WS_WR); const float* rowss = (const float*)(WSP + WS_ROWSS);
  unsigned* cnt = (unsigned*)(WSP + WS_CTL) + CW_CNT + layer * 32 * CW_CNT_STRIDE;
  int* tok_list = (int*)(WSP + WS_LIST); float* gate_list = (float*)(WSP + WS_LIST + 4 * MiB); int* tokslot = (int*)(WSP + WS_TOKSLOT);
  const int tid = opaque_tid(), lane = tid & 63, fr = lane & 15, fq = lane >> 4, wid = tid >> 6;
  constexpr int WPITCH = 2064;
  LAS unsigned char* Wl = lds; LAS float* gsl = (LAS float*)(lds + 66560); LAS float* shl = (LAS float*)(lds + 70656);
  LAS float* lg = (LAS float*)(lds + 74752) + wid * 512;
  LAS int* lcnt = (LAS int*)(lds + 91136); LAS int* gbase = lcnt + 32;
  for (int i = tid; i < 32 * 128; i += 512) { const int e = i >> 7, c = i & 127; *(LAS u32x4*)(Wl + e * WPITCH + c * 16) = *(const u32x4*)(Wr + (size_t)e * D + c * 8); }
  const float* ng = p.n2g + layer * D;
  for (int blk = blockIdx.x; blk < NTOK / 128; blk += gridDim.x) {
    const int b = (blk * 128) / SEQ;
    const float* shp = sm + SM_MOD + (layer * 4 + b) * 6144 + 3 * 1024; const float* scp = shp + 1024;
    __syncthreads();
    for (int i = tid; i < 1024; i += 512) { gsl[i] = ng[i] * (scp[i] + 1.0f); shl[i] = shp[i]; }
    if (tid < 32) lcnt[tid] = 0;
    __syncthreads();
    const int row = blk * 128 + wid * 16 + fr;
    const bf16_t* xr = X + (size_t)row * D + 8 * fq;
    float ss; { const f32x4 q = *(const f32x4*)(rowss + (size_t)row * 16 + 4 * fq); ss = (q[0] + q[1]) + (q[2] + q[3]); }
    ss += __shfl_xor(ss, 16); ss += __shfl_xor(ss, 32);
    const float rstd = rsqrtf(ss * (1.f / D) + EPS);
    f32x4 l0 = {0.f, 0.f, 0.f, 0.f}, l1 = {0.f, 0.f, 0.f, 0.f};
    const LAS unsigned char* w0 = Wl + fr * WPITCH + fq * 16; const LAS unsigned char* w1 = w0 + 16 * WPITCH;
#pragma unroll 8
    for (int kk = 0; kk < 32; ++kk) { const int c0 = 32 * kk + 8 * fq;
      const u32x4 xw = *(const u32x4*)(xr + 32 * kk);
      const f32x4 a = {__uint_as_float(xw.x << 16), __uint_as_float(xw.x & 0xffff0000u), __uint_as_float(xw.y << 16), __uint_as_float(xw.y & 0xffff0000u)};
      const f32x4 c = {__uint_as_float(xw.z << 16), __uint_as_float(xw.z & 0xffff0000u), __uint_as_float(xw.w << 16), __uint_as_float(xw.w & 0xffff0000u)};
      const f32x4 g0 = *(const LAS f32x4*)(gsl + c0), g1 = *(const LAS f32x4*)(gsl + c0 + 4), h0 = *(const LAS f32x4*)(shl + c0), h1 = *(const LAS f32x4*)(shl + c0 + 4);
      const f32x4 y0 = a * rstd * g0 + h0, y1 = c * rstd * g1 + h1;
      u32x4 w; w.x = cvtpk(y0[0], y0[1]); w.y = cvtpk(y0[2], y0[3]); w.z = cvtpk(y1[0], y1[1]); w.w = cvtpk(y1[2], y1[3]);
      { u32x2 q8; q8.x = pk4_fp8(y0[0], y0[1], y0[2], y0[3]); q8.y = pk4_fp8(y1[0], y1[1], y1[2], y1[3]); *(u32x2*)((unsigned char*)h2 + (size_t)row * D + c0) = q8; }
      const bf16x8 af = __builtin_bit_cast(bf16x8, w);
      const bf16x8 b0 = *(const LAS bf16x8*)(w0 + kk * 64), b1 = *(const LAS bf16x8*)(w1 + kk * 64);
      l0 = __builtin_amdgcn_mfma_f32_16x16x32_bf16(af, b0, l0, 0, 0, 0); l1 = __builtin_amdgcn_mfma_f32_16x16x32_bf16(af, b1, l1, 0, 0, 0); }
#pragma unroll
    for (int i = 0; i < 4; ++i) { lg[(4 * fq + i) * 32 + fr] = l0[i]; lg[(4 * fq + i) * 32 + 16 + fr] = l1[i]; }
    asm volatile("s_waitcnt lgkmcnt(0)" ::: "memory");
    int tok = 0, e1 = 0, e2 = 0, r1 = 0, r2 = 0; float g1 = 0.f, g2 = 0.f;
    if (lane < 16) {
      tok = blk * 128 + wid * 16 + lane;
      float pr[32]; float mx = -1e30f;
#pragma unroll
      for (int e = 0; e < 32; ++e) { pr[e] = lg[lane * 32 + e] + p.rb[e]; mx = fmaxf(mx, pr[e]); }
      float sum = 0.f;
#pragma unroll
      for (int e = 0; e < 32; ++e) { pr[e] = __expf(pr[e] - mx); sum += pr[e]; }
      const float inv = 1.0f / sum;
      float best = -1.f; int gsel = 0;
#pragma unroll
      for (int g = 0; g < 4; ++g) { float m1 = -1.f, m2 = -1.f;
#pragma unroll
        for (int k = 0; k < 8; ++k) { const float v = pr[g * 8 + k] * inv; if (v > m1) { m2 = m1; m1 = v; } else if (v > m2) m2 = v; }
        const float sc = m1 + m2; if (sc > best) { best = sc; gsel = g; } }
      float v1 = -1.f, v2 = -1.f; int i1 = 0, i2 = 0;
#pragma unroll
      for (int g = 0; g < 4; ++g) if (g == gsel) {
#pragma unroll
        for (int k = 0; k < 8; ++k) { const float v = pr[g * 8 + k] * inv; if (v > v1) { v2 = v1; i2 = i1; v1 = v; i1 = k; } else if (v > v2) { v2 = v; i2 = k; } } }
      e1 = gsel * 8 + i1; e2 = gsel * 8 + i2; const float gs = 1.0f / (v1 + v2); g1 = v1 * gs; g2 = v2 * gs;
      r1 = __hip_atomic_fetch_add(lcnt + e1, 1, __ATOMIC_RELAXED, __HIP_MEMORY_SCOPE_WORKGROUP); r2 = __hip_atomic_fetch_add(lcnt + e2, 1, __ATOMIC_RELAXED, __HIP_MEMORY_SCOPE_WORKGROUP);
    }
    __syncthreads();
    if (tid < 32) { const unsigned n = (unsigned)lcnt[tid]; gbase[tid] = n ? (int)atomicAdd(cnt + tid * CW_CNT_STRIDE, n) : 0; }
    __syncthreads();
    if (lane < 16) {
      const int p1 = gbase[e1] + r1, p2 = gbase[e2] + r2;
      tok_list[e1 * 32768 + p1] = tok; gate_list[e1 * 32768 + p1] = g1; tok_list[e2 * 32768 + p2] = tok; gate_list[e2 * 32768 + p2] = g2;
      tokslot[tok * 2] = e1 * 32768 + p1; tokslot[tok * 2 + 1] = e2 * 32768 + p2;
    }
    asm volatile("s_waitcnt lgkmcnt(0)" ::: "memory");
  }
}
DI int moe_tables(const Params& p, LAS int* T, int layer) {
  const unsigned* cnt = (const unsigned*)(WSP + WS_CTL) + CW_CNT + layer * 32 * CW_CNT_STRIDE;
  const int tid0 = opaque_tid();
  if (tid0 < 64) {
    const int lane = tid0, c = (lane < 32) ? (int)__hip_atomic_load(cnt + lane * CW_CNT_STRIDE, __ATOMIC_RELAXED, __HIP_MEMORY_SCOPE_AGENT) : 0;
    const int tiles = (c + 255) >> 8; int tp = tiles, sp = c;
#pragma unroll
    for (int d = 1; d < 32; d <<= 1) { const int a = __shfl_up(tp, d), b = __shfl_up(sp, d); if (lane >= d) { tp += a; sp += b; } }
    if (lane < 32) { T[lane] = tp - tiles; T[33 + lane] = sp - c; T[66 + lane] = c; }
    if (lane == 31) { T[32] = tp; T[65] = sp; } }
  __syncthreads();
  for (int t = opaque_tid(); t < T[32]; t += 512) { int e = 0; for (int k = 0; k < 32; ++k) e += (t >= T[k + 1]) ? 1 : 0; T[128 + t] = e; }
  __syncthreads();
  return T[32];
}
typedef float f32x2v __attribute__((ext_vector_type(2)));
DI void phase_combine(const Params& p, LAS int* T, int layer, bool make_h) {
  const float* sm = (const float*)(WSP + WS_SMALL);
  bf16_t* X = (bf16_t*)(WSP + WS_XR); const unsigned char* yb = (const unsigned char*)(WSP + WS_R0); const int* tokslot = (const int*)(WSP + WS_TOKSLOT);
  bf16_t* hout = (bf16_t*)(WSP + WS_R3); float* fout = p.out;
  const int tid = opaque_tid(), lane = tid & 63, gw = blockIdx.x * 8 + (tid >> 6), NGW = gridDim.x * 8;
  for (int r0 = gw * 2; r0 < NTOK; r0 += NGW * 2) { const int b = r0 / SEQ;
    const float* g2 = sm + SM_MOD + (layer * 4 + b) * 6144 + 5 * 1024;
    u32x2 xv[2][4]; unsigned ya[2][4], yc[2][4];
#pragma unroll
    for (int q = 0; q < 2; ++q) { const int r = r0 + q;
      const int ca = tokslot[r * 2], cb = tokslot[r * 2 + 1];
      const int sa = T[33 + (ca >> 15)] + (ca & 32767), sb = T[33 + (cb >> 15)] + (cb & 32767);
      const bf16_t* xr = X + (size_t)r * D; const unsigned char* pa = yb + (size_t)sa * D; const unsigned char* pb = yb + (size_t)sb * D;
#pragma unroll
      for (int j = 0; j < 4; ++j) { const int c = 4 * lane + 256 * j; xv[q][j] = *(const u32x2*)(xr + c); ya[q][j] = *(const unsigned*)(pa + c); yc[q][j] = *(const unsigned*)(pb + c); } }
#pragma unroll
    for (int q = 0; q < 2; ++q) { const int r = r0 + q; float s = 0.f; f32x4 v[4];
#pragma unroll
      for (int j = 0; j < 4; ++j) { const int c = 4 * lane + 256 * j; const f32x4 gg = *(const f32x4*)(g2 + c) * 0.0625f; const u32x2 xx = xv[q][j];
        const f32x2v a0 = __builtin_amdgcn_cvt_pk_f32_fp8((int)ya[q][j], false), a1 = __builtin_amdgcn_cvt_pk_f32_fp8((int)ya[q][j], true);
        const f32x2v b0 = __builtin_amdgcn_cvt_pk_f32_fp8((int)yc[q][j], false), b1 = __builtin_amdgcn_cvt_pk_f32_fp8((int)yc[q][j], true);
        const f32x4 ys = {a0[0] + b0[0], a0[1] + b0[1], a1[0] + b1[0], a1[1] + b1[1]};
        const f32x4 x0 = {__uint_as_float(xx.x << 16), __uint_as_float(xx.x & 0xffff0000u), __uint_as_float(xx.y << 16), __uint_as_float(xx.y & 0xffff0000u)};
        v[j] = x0 + gg * ys;
        if (make_h) { u32x2 w; w.x = cvtpk(v[j][0], v[j][1]); w.y = cvtpk(v[j][2], v[j][3]); *(u32x2*)(X + (size_t)r * D + c) = w; }
        else *(f32x4*)(fout + (size_t)r * D + c) = v[j];
        s += (v[j][0] * v[j][0] + v[j][1] * v[j][1]) + (v[j][2] * v[j][2] + v[j][3] * v[j][3]); }
      if (make_h) { const float rstd = rsqrtf(wave_sum(s) * (1.f / D) + EPS);
        const float* g = p.n1g + (layer + 1) * D; const float* shift = sm + SM_MOD + ((layer + 1) * 4 + b) * 6144; const float* scale = shift + 1024;
#pragma unroll
        for (int j = 0; j < 4; ++j) { const int c = 4 * lane + 256 * j; const f32x4 gg = *(const f32x4*)(g + c), sh = *(const f32x4*)(shift + c), sc = *(const f32x4*)(scale + c);
          const f32x4 y = v[j] * rstd * gg * (sc + 1.0f) + sh; u32x2 w; w.x = cvtpk(y[0], y[1]); w.y = cvtpk(y[2], y[3]); *(u32x2*)(hout + (size_t)r * D + c) = w; } }
    }
  }
}
DI void phase_pool(const Params& p, LAS unsigned char* lds) {
  const bf16_t* U = (const bf16_t*)(WSP + WS_R2); bf16_t* Dd = (bf16_t*)(WSP + WS_R3);
  const int tid = opaque_tid(), lane = tid & 63, wid = __builtin_amdgcn_readfirstlane(tid >> 6);
  const int c2 = tid;
  const int j = tid >> 7, hw = 1 << j;
  for (int tile = blockIdx.x; tile < NTOK / 32; tile += gridDim.x) {
    const int b = tile >> 8, t0 = (tile & 255) * 32;
    for (int r = wid; r < 96; r += 8) { const int row = t0 - 8 + (r >> 1);
      if (row >= 0 && row < SEQ) __builtin_amdgcn_global_load_lds((const unsigned*)((const char*)(U + (size_t)(b * SEQ + row) * D) + (r & 1) * 1024 + lane * 16), (LAS unsigned*)(lds + r * 1024), 16, 0, 0); }
    asm volatile("s_waitcnt vmcnt(0)" ::: "memory"); __syncthreads();
    const LAS unsigned* L = (const LAS unsigned*)lds + c2;
    float s0 = 0.f, s1 = 0.f;
    { const int lo = (t0 - hw) > 0 ? (t0 - hw) : 0, hi = (t0 + hw) < SEQ ? (t0 + hw) : SEQ;
      for (int tt = lo; tt < hi; ++tt) { const unsigned w = L[(tt - t0 + 8) * 512]; s0 += __uint_as_float(w << 16); s1 += __uint_as_float(w & 0xffff0000u); } }
#pragma unroll 4
    for (int i = 0; i < 32; ++i) { const int t = t0 + i;
      const int lo = (t - hw) > 0 ? (t - hw) : 0, hi = (t + hw) < SEQ ? (t + hw) : SEQ;
      const unsigned wc = L[(i + 8) * 512];
      const float inv = 1.0f / (float)(hi - lo);
      const unsigned o = cvtpk(s0 * inv - __uint_as_float(wc << 16), s1 * inv - __uint_as_float(wc & 0xffff0000u));
      *(unsigned*)(Dd + (size_t)(b * SEQ + t) * D + 2 * c2) = o;
      if (t + hw < SEQ) { const unsigned w = L[(i + 8 + hw) * 512]; s0 += __uint_as_float(w << 16); s1 += __uint_as_float(w & 0xffff0000u); }
      if (t - hw >= 0) { const unsigned w = L[(i + 8 - hw) * 512]; s0 -= __uint_as_float(w << 16); s1 -= __uint_as_float(w & 0xffff0000u); }
    }
    __syncthreads();
  }
}

constexpr int LDS_BYTES = 163840;
constexpr int LDS_TAB = 131072;
constexpr int LDS_MISC = LDS_TAB + 2048;
constexpr int LDS_STG = LDS_TAB + 2304;
constexpr int NPHASE = 17;

__global__ void __launch_bounds__(512, 2) fwd_megakernel(Params p) {
  extern __shared__ __attribute__((aligned(16))) unsigned char lds_raw[];
  LAS unsigned char* lds = (LAS unsigned char*)lds_raw;
  LAS int* T = (LAS int*)(lds + LDS_TAB);
  cg::grid_group grid = cg::this_grid();
  { volatile LAS unsigned* MISC0 = (volatile LAS unsigned*)(lds + LDS_MISC);
    if (threadIdx.x < 4) MISC0[threadIdx.x] = 0u; }
  __syncthreads();
  volatile LAS unsigned* MISC = (volatile LAS unsigned*)(lds + LDS_MISC);
  (void)xcd_barrier_post((unsigned*)(WSP + WS_CTL) + CW_BAR, MISC);
#define XBAR() do { XcdBarrier xb_; xb_.bar = (unsigned*)(WSP + WS_CTL) + CW_BAR; xb_.x = xb_xcc_id(); xb_.st = (volatile LAS unsigned*)(lds + LDS_MISC); xcd_barrier(xb_); } while (0)
#define SMP ((const float*)(WSP + WS_SMALL))
#ifndef PHMASK
#define PHMASK 0xffffffffu
#endif
#ifndef REP_PHASE
#define REP_PHASE (-1)
#endif
#define IN(k) (((PHMASK >> ((k) & 31)) & 1u) != 0u)
#define REPS(k) for (int rep_ = 0; rep_ < (((k) == REP_PHASE) ? 2 : 1); ++rep_)
#ifndef USE_CG
#define SEAM(k) do { if (IN(k) && IN((k) + 1)) { XBAR(); } } while (0)
#else
#define SEAM(k) do { if (IN(k) && IN((k) + 1)) grid.sync(); } while (0)
#endif
  if (p.ph_lo == 0x7fffffff) grid.sync();
  if (IN(0)) REPS(0) { phase_mods(p, lds); __syncthreads(); }
  SEAM(0);
  if (IN(1)) REPS(1) { phase_hcat(p); phase_weights_small(p, lds); __syncthreads(); }
  SEAM(1);
  if (IN(2)) REPS(2) {
    EpiQKV E{EpiQK{WSP + WS_R1, WSP + WS_R2, p.qg, p.kg, SMP + SM_ROPE}, EpiVt{(unsigned char*)(WSP + WS_R3)}};
    SchedQKV S; S.init(WSP + WS_R0, WSP + WS_WQK, WSP + WS_WV);
    pg8::gemm_phase<EpiQKV, SchedQKV, pg8::PermQK, false, pg8::PermV, true, true>(lds, 1024, 1024, 1024, S, E);
    __syncthreads();
    { EpiBf16 Ef{(bf16_t*)(WSP + WS_WPF), 1024, nullptr, 0}; SchedFold Sf; Sf.init(WSP + WS_WPO, WSP + WS_WPG);
      pg8::gemm_phase<EpiBf16, SchedFold, pg8::Perm8, false>(lds, 2048, 512, 256, Sf, Ef); __syncthreads(); }
    phase_weights_moe(p, lds);
  }
  SEAM(2);
  if (IN(3)) REPS(3) phase_attn(p, lds);
  SEAM(3);
  if (IN(4)) REPS(4) { EpiResid<true> E{p.x, (bf16_t*)(WSP + WS_XR), SMP + SM_MOD + 2 * 1024, (float*)(WSP + WS_ROWSS)};
    SchedGrid S; S.init(WSP + WS_R0, WSP + WS_WO, 2048, 2048, 128, 4);
    pg8::gemm_phase<EpiResid<true>, SchedGrid, pg8::Perm8, false>(lds, 2048, 2048, 1024, S, E); }
  SEAM(4);
  for (int layer = 0; layer < 2; ++layer) {
    const int P = 5 + layer * 8;
    if (IN(P)) phase_router(p, lds, layer);
    SEAM(P);
    if (IN(P + 1)) REPS(P + 1) { const int nt = moe_tables(p, T, layer);
      EpiAct E{(bf16_t*)(WSP + WS_R2)};
      typedef SchedMoe<true, 1024 * 1024, 256 * 1024, 1024> SM1; SM1 S; S.T = T; S.A0 = (const char*)(WSP + WS_R1); S.W0 = (const char*)(WSP + WS_WGU + (size_t)layer * 32 * MiB);
      S.tok = (const int*)(WSP + WS_LIST); S.dl.init(nt * 4);
      pg8::gemm_phase<EpiAct, SM1, pg8::Perm8, true, pg8::Perm8, false, true, true>(lds, 1024, 1024, 1024, S, E); }
    SEAM(P + 1);
    if (IN(P + 2)) REPS(P + 2) { const int nt = T[32];
      EpiY E{(unsigned char*)(WSP + WS_R0), (const float*)(WSP + WS_LIST + 4 * MiB)};
      typedef SchedMoe<false, 1024 * 512, 256 * 512, 512> SM2; SM2 S; S.T = T; S.A0 = (const char*)(WSP + WS_R2); S.W0 = (const char*)(WSP + WS_WD + (size_t)layer * 16 * MiB);
      S.tok = nullptr; S.dl.init(nt * 4);
      pg8::gemm_phase<EpiY, SM2, pg8::Perm8, false, pg8::Perm8, false, true, true>(lds, 512, 512, 512, S, E); }
    SEAM(P + 2);
    if (IN(P + 3)) { phase_combine(p, T, layer, layer == 0); }
    if (layer == 0) {
      SEAM(8);
      if (IN(9)) REPS(9) { EpiBf16 E{(bf16_t*)(WSP + WS_R2), 1024, nullptr, 0};
        SchedGrid S; S.init(WSP + WS_R3, WSP + WS_WPI, 2048, 2048, 128, 4);
        pg8::gemm_phase<EpiBf16, SchedGrid, pg8::Perm8, false>(lds, 2048, 2048, 1024, S, E); }
      SEAM(9);
      if (IN(10)) REPS(10) phase_pool(p, lds);
      SEAM(10);
      if (IN(12)) { EpiResid<false> E{nullptr, (bf16_t*)(WSP + WS_XR), SMP + SM_MOD + 4 * 6144 + 2 * 1024, (float*)(WSP + WS_ROWSS)};
        SchedGrid S; S.init(WSP + WS_R3, WSP + WS_WPF, 2048, 2048, 128, 4);
        pg8::gemm_phase<EpiResid<false>, SchedGrid, pg8::Perm8, false>(lds, 2048, 2048, 1024, S, E); }
      SEAM(12);
    }
  }
#undef IN
#undef SEAM
#undef SMP
}

extern "C" void kernel_launch(void* const* d_in, const int* in_sizes, int n_in, void* d_out, int out_size,
                              void* d_ws, size_t ws_size, hipStream_t stream) {
  static int grid_blocks = 0;
  if (grid_blocks == 0) {
    int dev = 0, cus = 0, per_cu = 0;
    if (n_in != 26 || out_size != NTOK * D || ws_size < WS_END) { fprintf(stderr, "kernel_launch: unexpected shapes (n_in %d out %d ws %zu)\n", n_in, out_size, ws_size); grid_blocks = -1; return; }
    (void)hipGetDevice(&dev); (void)hipDeviceGetAttribute(&cus, hipDeviceAttributeMultiprocessorCount, dev);
    (void)hipFuncSetAttribute((const void*)fwd_megakernel, hipFuncAttributeMaxDynamicSharedMemorySize, LDS_BYTES);
    (void)hipOccupancyMaxActiveBlocksPerMultiprocessor(&per_cu, (const void*)fwd_megakernel, 512, LDS_BYTES);
    if (per_cu < 1) fprintf(stderr, "kernel_launch: occupancy query says %d\n", per_cu);
    (void)hipGetLastError();
    grid_blocks = cus;
  }
  if (grid_blocks < 0) return;
  (void)hipMemsetAsync((char*)d_ws + WS_CTL, 0, 32768, stream);
  Params p{};
  const float** pp = (const float**)&p;
  for (int i = 0; i < 26; ++i) pp[i] = (const float*)d_in[i];
  p.out = (float*)d_out; p.ws = (unsigned char*)d_ws; p.ph_lo = 0; p.ph_hi = 0;
  void* args[] = {&p};
  hipError_t e = hipLaunchCooperativeKernel((void*)fwd_megakernel, dim3(grid_blocks), dim3(512), args, LDS_BYTES, stream);
  if (e != hipSuccess) fprintf(stderr, "cooperative launch failed: %s (grid %d)\n", hipGetErrorString(e), grid_blocks);
}
```

```cpp
#include <hip/hip_runtime.h>
#include <hip/hip_cooperative_groups.h>
#include <cstdio>
#include <cstdint>
namespace cg = cooperative_groups;

#define LAS __attribute__((address_space(3)))
#define DI __device__ __forceinline__
typedef unsigned short bf16_t;
typedef short bf16x8 __attribute__((ext_vector_type(8)));
typedef float f32x4 __attribute__((ext_vector_type(4)));
typedef float f32x16 __attribute__((ext_vector_type(16)));
typedef float f32x2_t __attribute__((ext_vector_type(2)));
typedef __bf16 bf16x2_t __attribute__((ext_vector_type(2)));
typedef unsigned u32x4 __attribute__((ext_vector_type(4)));
typedef unsigned u32x2 __attribute__((ext_vector_type(2)));
typedef int v8i_t __attribute__((ext_vector_type(8)));

constexpr int D = 1024, NB = 4, SEQ = 8192, CTXL = 256, KV = SEQ + CTXL  , NTOK = NB * SEQ  , NROWS = NB * KV  ;
constexpr int NH = 8, HD = 64, VD = 128, NE = 32, DE = 512, NKT = KV / 64  ;
constexpr int NASSIGN = NTOK * 2;
constexpr float EPS = 1e-6f;
constexpr float LOG2E = 1.4426950408889634f;
constexpr float C2 = 0.125f * LOG2E;

constexpr int LDS_STG_OFF = 131072 + 2304;
constexpr size_t MiB = 1u << 20;
constexpr size_t WS_CTL = 0;
constexpr size_t WS_SMALL = 1 * MiB;
constexpr size_t WS_LIST = 2 * MiB;
constexpr size_t WS_TOKSLOT = 1 * MiB + 512 * 1024;
constexpr size_t WS_ROWSS = 10 * MiB;
constexpr size_t WS_WQK = 12 * MiB;
constexpr size_t WS_WPF = 14 * MiB;
constexpr size_t WS_WV = 16 * MiB;
constexpr size_t WS_WO = 18 * MiB;
constexpr size_t WS_WPI = 20 * MiB;
constexpr size_t WS_WPG = 22 * MiB;
constexpr size_t WS_WPO = 23 * MiB;
constexpr size_t WS_WR = 25 * MiB;
constexpr size_t WS_WGU = 26 * MiB;
constexpr size_t WS_WD = 154 * MiB;
constexpr size_t WS_R0 = 218 * MiB;
constexpr size_t WS_R1 = 284 * MiB;
constexpr size_t WS_R2 = 348 * MiB;
constexpr size_t WS_R3 = 414 * MiB;
constexpr size_t WS_XR = 480 * MiB;
constexpr size_t WS_END = 544 * MiB;
constexpr int CW_BAR = 4096;
constexpr int CW_WQ = 512;
constexpr int CW_CNT = 1024, CW_CNT_STRIDE = 32;
constexpr int SM_MOD = 0;
constexpr int SM_MODC = 2 * 4 * 6144;
constexpr int SM_SCAL = SM_MODC + 2048;
constexpr int SM_ROPE = SM_SCAL + 64;

struct Params {
  const float *x, *c, *ctx, *c_ctx, *ada_w, *ada_b, *n1g, *n2g, *w_in, *w_out, *qg, *kg, *lq1, *lk1, *lq2, *lk2, *subg,
      *pw_in, *pw_g, *pscale, *pw_out, *rw, *rb, *wg, *wu, *wd;
  float* out; unsigned char* ws;
  int ph_lo, ph_hi;
};

DI unsigned cvtpk(float lo, float hi) { f32x2_t v = {lo, hi}; bf16x2_t b = __builtin_convertvector(v, bf16x2_t); return __builtin_bit_cast(unsigned, b); }
DI unsigned pk4_fp8(float a, float b, float c, float d) { int w = 0; w = __builtin_amdgcn_cvt_pk_fp8_f32(a, b, w, false); w = __builtin_amdgcn_cvt_pk_fp8_f32(c, d, w, true); return (unsigned)w; }
DI float bf2f(unsigned short u) { return __uint_as_float(((unsigned)u) << 16); }
DI float wave_sum(float v) {
#pragma unroll
  for (int o = 1; o < 64; o <<= 1) v += __shfl_xor(v, o);
  return v;
}
DI float silu_f(float v) { return v / (1.f + __expf(-v)); }

DI int opaque_tid() { int t = threadIdx.x; asm volatile("" : "+v"(t)); return t; }
#define GAS __attribute__((address_space(1)))
#define WSP ({ GAS unsigned char* w_ = (GAS unsigned char*)p.ws; asm volatile("" : "+s"(w_)); (unsigned char*)w_; })


#define XB_TMO      128
#define XB_XCNT(j)  (256  + 64 * (j))
#define XB_XSUB(j)  (1280 + 64 * (j))
#define XB_XGEN(j)  (2304 + 64 * (j))
#define XB_TOP      3328
#define XB_TOPGEN   3392
#define XCD_BAR_WORDS 3456
#define XB_SPIN_CAP (1u << 18)
DI unsigned xb_ld(unsigned* p)              { return __hip_atomic_load(p, __ATOMIC_RELAXED, __HIP_MEMORY_SCOPE_AGENT); }
DI unsigned xb_add(unsigned* p, unsigned v) { return __hip_atomic_fetch_add(p, v, __ATOMIC_RELAXED, __HIP_MEMORY_SCOPE_AGENT); }
DI unsigned xb_xcc_id() { return (unsigned)__builtin_amdgcn_s_getreg((3 << 11) | 20) & 0xFu; }
#define XB_SPIN(cond, bar) do { unsigned _sp = 0; while (cond) { __builtin_amdgcn_s_sleep(1); \
    if ((++_sp & 255u) == 0u) { if (xb_ld(&(bar)[XB_TMO])) break; if (_sp > XB_SPIN_CAP) { atomicAdd(&(bar)[XB_TMO], 1u); break; } } } } while (0)
struct XcdBarrier { unsigned* bar; unsigned x; volatile LAS unsigned* st; };
DI XcdBarrier xcd_barrier_post(unsigned* bar, volatile LAS unsigned* st) {
  XcdBarrier b; b.bar = bar; b.x = xb_xcc_id(); b.st = st;
  if (threadIdx.x == 0) (void)xb_add(&bar[XB_XCNT(b.x)], 1u);
  return b;
}
DI void xcd_barrier_complete(unsigned* bar, unsigned x, unsigned& nloc, unsigned& nx) {
  const unsigned G = gridDim.x * gridDim.y * gridDim.z;
  unsigned sum, cnt, mine, sp = 0u;
  for (;;) {
    sum = 0u; cnt = 0u; mine = 0u;
#pragma unroll
    for (unsigned j = 0; j < 16; ++j) { const unsigned c = xb_ld(&bar[XB_XCNT(j)]); sum += c; cnt += (c > 0u) ? 1u : 0u; mine = (j == x) ? c : mine; }
    if (sum == G) break;
    __builtin_amdgcn_s_sleep(1);
    if ((++sp & 255u) == 0u) { if (xb_ld(&bar[XB_TMO])) break; if (sp > XB_SPIN_CAP) { atomicAdd(&bar[XB_TMO], 1u); break; } }
  }
  nloc = mine > 0u ? mine : 1u; nx = cnt > 0u ? cnt : 1u;
}
DI void xcd_barrier(const XcdBarrier& b) {
  asm volatile("s_waitcnt vmcnt(0)" ::: "memory");
  __syncthreads();
  if (threadIdx.x == 0) {
    unsigned* bar = b.bar;
    __builtin_amdgcn_s_waitcnt(0);
    unsigned nloc = b.st[0], nx = b.st[1];
    if (nloc == 0u) { xcd_barrier_complete(bar, b.x, nloc, nx); b.st[0] = nloc; b.st[1] = nx; }
    const unsigned old = xb_add(&bar[XB_XSUB(b.x)], 1u);
    const unsigned gen = old / nloc;
    if (old + 1u == (gen + 1u) * nloc) {
      __builtin_amdgcn_fence(__ATOMIC_RELEASE, "agent");
      asm volatile("s_waitcnt vmcnt(0)" ::: "memory");
      const unsigned og = xb_add(&bar[XB_TOP], 1u);
      const unsigned tg = og / nx;
      if (og + 1u == (tg + 1u) * nx) xb_add(&bar[XB_TOPGEN], 1u);
      else XB_SPIN(xb_ld(&bar[XB_TOPGEN]) == tg, bar);
      __builtin_amdgcn_fence(__ATOMIC_ACQUIRE, "agent");
      xb_add(&bar[XB_XGEN(b.x)], 1u);
      asm volatile("s_waitcnt vmcnt(0)" ::: "memory");
    } else {
      XB_SPIN(xb_ld(&bar[XB_XGEN(b.x)]) == gen, bar);
      __builtin_amdgcn_fence(__ATOMIC_ACQUIRE, "agent");
      asm volatile("s_waitcnt vmcnt(0)" ::: "memory");
    }
  }
  __syncthreads();
}

namespace pg8 {
constexpr int BM = 256, BK = 64, HALF = 128, HTB = HALF * BK * 2, STAGE_BYTES = 8 * HTB;
DI int lds_byte(int r, int c) { const int st = (r >> 4) * 2 + (c >> 5), rr = r & 15, cc = c & 31, ob = rr * 64 + cc * 2; return st * 1024 + (ob ^ (((ob >> 9) & 1) << 5)); }
DI void stage_rc(int b, int& R, int& C) { const int st = b / 1024, sb = b % 1024, swz = sb ^ (((sb >> 9) & 1) << 5); R = (st >> 1) * 16 + swz / 64; C = (st & 1) * 32 + (swz % 64) / 2; }

DI void glds16s(const char* sbase_, unsigned voff, unsigned lds_dst) { unsigned keep;
  const char* sbase = (const char*)(((size_t)(unsigned)__builtin_amdgcn_readfirstlane((int)((size_t)sbase_ >> 32)) << 32) | (size_t)(unsigned)__builtin_amdgcn_readfirstlane((int)(size_t)sbase_));
  asm volatile("s_nop 2\n\ts_mov_b32 %0, m0\n\ts_mov_b32 m0, %3\n\ts_nop 0\n\tglobal_load_lds_dwordx4 %1, %2\n\ts_mov_b32 m0, %0" : "=&s"(keep) : "v"(voff), "s"(sbase), "s"(lds_dst) : "memory"); }
struct Unit { const char* A; const char* B; int i0, i1, i2, i3; };

struct PermNone { static constexpr int HALF_ROWS = 128; static DI int src(int s) { return s; } };
struct Perm8 { static constexpr int HALF_ROWS = 128; static DI int src(int s) { const int r = s & 31, n = r >> 4, i = r & 15; return (s & ~31) + 8 * (i >> 2) + 4 * n + (i & 3); } };
struct PermQK { static constexpr int HALF_ROWS = 4; static DI int src(int s) { return (((s >> 5) & 3) << 6) | (((s >> 3) & 1) << 5) | (((s >> 4) & 1) << 4) | (((s >> 2) & 1) << 3) | (((s >> 7) & 1) << 2) | (s & 3); } };
struct PermV { static constexpr int HALF_ROWS = 16; static DI int src(int s) { return (((s >> 5) & 3) << 6) | (((s >> 3) & 1) << 5) | (((s >> 7) & 1) << 4) | (((s >> 4) & 1) << 3) | (((s >> 2) & 1) << 2) | (s & 3); } };

template <class Epi, class Sched, class BPerm, bool GATHER, class BPerm1 = BPerm, bool DYNB = false, bool FP8 = false, bool HALFSKIP = false>
DI void gemm_phase(LAS unsigned char* lds, const int lda  , const int ldb  , const int K, const Sched& S, const Epi& E) {
  int tid_ = threadIdx.x; asm volatile("" : "+v"(tid_));
  const int tid = tid_, wid = __builtin_amdgcn_readfirstlane(tid >> 6), lane = tid & 63, wr = wid >> 2, wc = wid & 3, fr = lane & 15, fq = lane >> 4;
  int Kk = K; asm volatile("" : "+s"(Kk));
  const int nt = FP8 ? Kk / 128 : Kk / BK;
  int sR[2], sC[2];
#pragma unroll
  for (int i = 0; i < 2; ++i) stage_rc(tid * 16 + i * 8192, sR[i], sC[i]);
  unsigned vA[2][2], vAn[2][2], vB[2], vBn[2];
#pragma unroll
  for (int i = 0; i < 2; ++i) { vB[i] = (unsigned)(BPerm::src(sR[i]) * ldb + sC[i] * 2); vBn[i] = vB[i]; vA[0][i] = (unsigned)(sR[i] * lda + sC[i] * 2); vA[1][i] = vA[0][i]; vAn[0][i] = vA[0][i]; vAn[1][i] = vA[0][i]; }
  const size_t kstep = (size_t)(BK * 2);
  const size_t hA = GATHER ? (size_t)0 : (size_t)128 * lda; size_t hB = (size_t)BPerm::HALF_ROWS * ldb, hBn = hB;
  const unsigned ldsw = (unsigned)wid * 1024u;
  const int aoff = lds_byte(wr * 64 + fr, fq * 8), boff = lds_byte(wc * 32 + fr, fq * 8);
#define PG8_SA(b, h) (((b) * 2 + (h)) * HTB)
#define PG8_SB(b, h) ((4 + (b) * 2 + (h)) * HTB)
#define PG8_STAGE(bufoff, gbase, v0, v1) do { \
    glds16s((const char*)(gbase), (v0), (unsigned)__builtin_amdgcn_readfirstlane((int)((unsigned)(size_t)lds + (unsigned)(bufoff) + ldsw))); \
    glds16s((const char*)(gbase), (v1), (unsigned)__builtin_amdgcn_readfirstlane((int)((unsigned)(size_t)lds + (unsigned)(bufoff) + ldsw + 8192u))); } while (0)
#define PG8_STA(b, h, base, W) PG8_STAGE(PG8_SA(b, h), (base) + (h) * hA, W[GATHER ? (h) : 0][0], W[GATHER ? (h) : 0][1])
#define PG8_STB(b, h, base) PG8_STAGE(PG8_SB(b, h), (base) + (h) * hB, vB[0], vB[1])
#define PG8_STB2(b, h, base) PG8_STAGE(PG8_SB(b, h), (base) + (h) * hB2, vB2[0], vB2[1])
#define PG8_RD(off) (*(const LAS u32x4*)(lds + (off)))
#define PG8_CAT2(lo, hi) __builtin_bit_cast(v8i_t, __builtin_shufflevector((lo), (hi), 0, 1, 2, 3, 4, 5, 6, 7))
#define PG8_LDA(dst, b, h) do { _Pragma("unroll") for (int m = 0; m < 4; ++m) dst[m] = PG8_CAT2(PG8_RD(PG8_SA(b, h) + aoff + m * 2048), PG8_RD(PG8_SA(b, h) + aoff + m * 2048 + 1024)); } while (0)
#define PG8_LDB(dst, b, h) do { _Pragma("unroll") for (int n = 0; n < 2; ++n) dst[n] = PG8_CAT2(PG8_RD(PG8_SB(b, h) + boff + n * 2048), PG8_RD(PG8_SB(b, h) + boff + n * 2048 + 1024)); } while (0)
#define PG8_LO(X) __builtin_bit_cast(bf16x8, __builtin_shufflevector((X), (X), 0, 1, 2, 3))
#define PG8_HI(X) __builtin_bit_cast(bf16x8, __builtin_shufflevector((X), (X), 4, 5, 6, 7))
#define PG8_MMA(ai, bj, At, Bt) do { __builtin_amdgcn_s_setprio(1); \
      if constexpr (FP8) { _Pragma("unroll") for (int m = 0; m < 4; ++m) _Pragma("unroll") for (int n = 0; n < 2; ++n) \
        asm volatile("v_mfma_scale_f32_16x16x128_f8f6f4 %0, %1, %2, %0, %3, %4 op_sel_hi:[0,0,0]" : "+v"(acc[ai][bj][m][n]) : "v"(Bt[n]), "v"(At[m]), "v"(scw), "v"(sca)); } \
      else { _Pragma("unroll") for (int m = 0; m < 4; ++m) _Pragma("unroll") for (int n = 0; n < 2; ++n) { \
        acc[ai][bj][m][n] = __builtin_amdgcn_mfma_f32_16x16x32_bf16(PG8_LO(Bt[n]), PG8_LO(At[m]), acc[ai][bj][m][n], 0, 0, 0); \
        acc[ai][bj][m][n] = __builtin_amdgcn_mfma_f32_16x16x32_bf16(PG8_HI(Bt[n]), PG8_HI(At[m]), acc[ai][bj][m][n], 0, 0, 0); } } \
      __builtin_amdgcn_s_setprio(0); } while (0)
#define PG8_WAIT_V(n) asm volatile("s_waitcnt vmcnt(" #n ")" ::: "memory")
#define PG8_WAIT_L(n) asm volatile("s_waitcnt lgkmcnt(" #n ")" ::: "memory")
#define PG8_BAR __builtin_amdgcn_s_barrier()
#define PG8_SCHED __builtin_amdgcn_sched_barrier(0)
  Unit cur, nxt; int ui = 0;
  if (!S.next(0, cur)) return;
  if constexpr (GATHER) {
#pragma unroll
    for (int h = 0; h < 2; ++h)
#pragma unroll
      for (int i = 0; i < 2; ++i) { vA[h][i] = (unsigned)(S.arow(cur, 128 * h + sR[i]) * lda + sC[i] * 2); vAn[h][i] = vA[h][i]; }
  }
  if constexpr (DYNB) { if (S.bkind(cur)) {
#pragma unroll
      for (int i = 0; i < 2; ++i) vB[i] = (unsigned)(BPerm1::src(sR[i]) * ldb + sC[i] * 2);
      hB = (size_t)BPerm1::HALF_ROWS * ldb; }
    vBn[0] = vB[0]; vBn[1] = vB[1]; hBn = hB; }
  f32x4 acc[2][2][4][2];
#pragma unroll
  for (int a = 0; a < 2; ++a)
#pragma unroll
    for (int b = 0; b < 2; ++b)
#pragma unroll
      for (int m = 0; m < 4; ++m)
#pragma unroll
        for (int n = 0; n < 2; ++n) acc[a][b][m][n] = (f32x4){0.f, 0.f, 0.f, 0.f};
  int scw = 122, sca = 127;
  asm volatile("" : "+v"(scw), "+v"(sca));
  v8i_t At[4], B0[2], B1[2];
  const char* cA = cur.A; const char* cB = cur.B;
  PG8_STB(0, 0, cB); PG8_STB(0, 1, cB); PG8_STA(0, 0, cA, vA); PG8_STA(0, 1, cA, vA);
  if (wr == 1) PG8_BAR;
  PG8_WAIT_V(2); PG8_BAR;
  PG8_STB(1, 0, cB + kstep); PG8_STA(1, 0, cA + kstep, vA); PG8_STB(1, 1, cB + kstep);
  PG8_WAIT_V(6); PG8_BAR;
  for (;;) {
    const bool has_next = S.next(ui + 1, nxt);
    const char* nA = has_next ? nxt.A : cA; const char* nB = has_next ? nxt.B : cB;
    if constexpr (DYNB) {
      if (has_next) { const bool k1 = S.bkind(nxt);
#pragma unroll
        for (int i = 0; i < 2; ++i) { int r_, c_; stage_rc(opaque_tid() * 16 + i * 8192, r_, c_); vBn[i] = (unsigned)((k1 ? BPerm1::src(r_) : BPerm::src(r_)) * ldb + c_ * 2); }
        hBn = (size_t)(k1 ? BPerm1::HALF_ROWS : BPerm::HALF_ROWS) * ldb; }
    }
    if constexpr (GATHER) {
      if (has_next) {
#pragma unroll
        for (int h = 0; h < 2; ++h)
#pragma unroll
          for (int i = 0; i < 2; ++i) { int r_, c_; stage_rc(opaque_tid() * 16 + i * 8192, r_, c_); vAn[h][i] = (unsigned)(S.arow(nxt, 128 * h + r_) * lda + c_ * 2); }
      }
    }
    const bool full_ = !HALFSKIP || (__builtin_amdgcn_readfirstlane(cur.i1) > 128);
    for (int t = 0; t < nt; t += 2) {
      const bool last = (t == nt - 2);
      const char* a1 = cA + (size_t)(t + 1) * kstep;
      const char* a2 = last ? nA : cA + (size_t)(t + 2) * kstep; const char* b2 = last ? nB : cB + (size_t)(t + 2) * kstep;
      const char* a3 = a2 + kstep; const char* b3 = b2 + kstep;
      unsigned w2[2][2];
#pragma unroll
      for (int h = 0; h < 2; ++h)
#pragma unroll
        for (int i = 0; i < 2; ++i) w2[h][i] = (GATHER && last) ? vAn[h][i] : vA[h][i];
      unsigned vB2[2]; size_t hB2 = hB;
#pragma unroll
      for (int i = 0; i < 2; ++i) vB2[i] = (DYNB && last) ? vBn[i] : vB[i];
      if (DYNB && last) hB2 = hBn;
      PG8_LDB(B0, 0, 0); PG8_LDB(B1, 0, 1); PG8_SCHED; PG8_LDA(At, 0, 0); PG8_STA(1, 1, a1, vA);
      PG8_WAIT_V(8); PG8_WAIT_L(0); PG8_BAR; PG8_MMA(0, 0, At, B0); PG8_MMA(0, 1, At, B1); PG8_BAR; PG8_SCHED;
      if (full_) { PG8_LDA(At, 0, 1); } PG8_STB2(0, 0, b2); PG8_STB2(0, 1, b2); PG8_STA(0, 0, a2, w2);
      PG8_WAIT_V(8); PG8_WAIT_L(0); PG8_BAR; if (full_) { PG8_MMA(1, 0, At, B0); PG8_MMA(1, 1, At, B1); } PG8_BAR; PG8_SCHED;
      PG8_LDB(B0, 1, 0); PG8_LDB(B1, 1, 1); PG8_SCHED; PG8_LDA(At, 1, 0); PG8_STA(0, 1, a2, w2);
      PG8_WAIT_V(8); PG8_WAIT_L(0); PG8_BAR; PG8_MMA(0, 0, At, B0); PG8_MMA(0, 1, At, B1); PG8_BAR; PG8_SCHED;
      if (full_) { PG8_LDA(At, 1, 1); } PG8_STB2(1, 0, b3); PG8_STB2(1, 1, b3); PG8_STA(1, 0, a3, w2);
      PG8_WAIT_V(8); PG8_WAIT_L(0); PG8_BAR; if (full_) { PG8_MMA(1, 0, At, B0); PG8_MMA(1, 1, At, B1); } PG8_BAR; PG8_SCHED;
    }
    if (wr == 0) PG8_BAR;
    if constexpr (FP8) {
#define PG8_T4(ai, bj) "+v"(acc[ai][bj][0][0]), "+v"(acc[ai][bj][0][1]), "+v"(acc[ai][bj][1][0]), "+v"(acc[ai][bj][1][1]), "+v"(acc[ai][bj][2][0]), "+v"(acc[ai][bj][2][1]), "+v"(acc[ai][bj][3][0]), "+v"(acc[ai][bj][3][1])
      asm volatile("s_nop 15\n\ts_nop 15" : PG8_T4(0, 0), PG8_T4(0, 1) :: "memory");
      asm volatile("" : PG8_T4(1, 0), PG8_T4(1, 1) :: "memory");
#undef PG8_T4
    }
    if constexpr (Epi::STAGED) E.staged(acc, cur, wr, wc, fr, fq, lds); else E(acc, cur, wr, wc, fr, fq);
    if (!has_next) break;
#pragma unroll
    for (int a = 0; a < 2; ++a)
#pragma unroll
      for (int b = 0; b < 2; ++b)
#pragma unroll
        for (int m = 0; m < 4; ++m)
#pragma unroll
          for (int n = 0; n < 2; ++n) acc[a][b][m][n] = (f32x4){0.f, 0.f, 0.f, 0.f};
    cur = nxt; cA = nA; cB = nB; ++ui;
    if constexpr (DYNB) { vB[0] = vBn[0]; vB[1] = vBn[1]; hB = hBn; }
    if constexpr (GATHER) {
#pragma unroll
      for (int h = 0; h < 2; ++h)
#pragma unroll
        for (int i = 0; i < 2; ++i) vA[h][i] = vAn[h][i];
    }
    if (wr == 1) PG8_BAR;
  }
  PG8_WAIT_V(0);
  PG8_BAR;
#undef PG8_SA
#undef PG8_SB
#undef PG8_STAGE
#undef PG8_STA
#undef PG8_STB
#undef PG8_STB2
#undef PG8_LDA
#undef PG8_LDB
#undef PG8_MMA
#undef PG8_RD
#undef PG8_CAT2
#undef PG8_LO
#undef PG8_HI
#undef PG8_WAIT_V
#undef PG8_WAIT_L
#undef PG8_BAR
#undef PG8_SCHED
}
}
using pg8::Unit;

struct Deal {
  int x, j, Ux, U;
  DI void init(int U_) { const int G = gridDim.x, bx = blockIdx.x; int v = (G % 8 == 0) ? (bx % 8) * (G / 8) + bx / 8 : bx; const int per = (G % 8 == 0) ? G / 8 : G;
    U = U_; if (G % 8 == 0) { x = v / per; j = v % per; Ux = (U + 7) / 8; } else { x = 0; j = v; Ux = U; } }
  DI int per() const { return (gridDim.x % 8 == 0) ? gridDim.x / 8 : gridDim.x; }
  DI int id(int i) const { const int t = j + i * per(); if (t >= Ux) return -1; const int g = x * Ux + t; return g < U ? g : -1; }
};


struct EpiQK { static constexpr bool STAGED = false;
  unsigned char* Q; unsigned char* Kt; const float* qg; const float* kg; const float* rope;
  DI void operator()(const f32x4 (&acc)[2][2][4][2], const Unit& u, int wr, int wc, int fr_, int fq_) const {
    int fr = fr_, fq = fq_; asm volatile("" : "+v"(fr), "+v"(fq));
    const int pm = u.i0, pn = u.i1;
    const int b = pm / 33, pt = pm % 33;
    const bool isq = pn < 4;
    if (isq && pt == 32) return;
    const int g = 4 * (pn & 3) + wc, hh = g >> 1, comp = g & 1;
    const float* gain = isq ? qg : kg;
    const int fq1 = fq >> 1, fq0 = fq & 1;
    const float qs = isq ? 1.4426950408889634f : 1.0f;
    const float* gp = gain + 32 * fq1 + 8 * fq0;
#pragma unroll
    for (int ai = 0; ai < 2; ++ai)
#pragma unroll
      for (int m = 0; m < 4; ++m) {
        const int pos = pt * 256 + 128 * ai + 64 * wr + 16 * m + fr;
        float ss = 0.f;
#pragma unroll
        for (int bj = 0; bj < 2; ++bj)
#pragma unroll
          for (int n = 0; n < 2; ++n) { const f32x4 v = acc[ai][bj][m][n]; ss += (v[0] * v[0] + v[1] * v[1]) + (v[2] * v[2] + v[3] * v[3]); }
        ss += __shfl_xor(ss, 16); ss += __shfl_xor(ss, 32);
        const float rstd = rsqrtf(ss * (1.0f / 64.0f) + EPS) * qs;
        const bool dorope = pos < SEQ;
        const int pp = fq1 ? (pos & 63) : ((pos >> 6) & 127);
        const float* rp = rope + (pp * 16 + 8 * fq0) * 2;
        u32x4 w;
#pragma unroll
        for (int bj = 0; bj < 2; ++bj) {
          const f32x4 g0 = *(const f32x4*)(gp + 4 * bj), g1 = *(const f32x4*)(gp + 16 + 4 * bj);
          f32x4 y0 = acc[ai][bj][m][0] * rstd * g0, y1 = acc[ai][bj][m][1] * rstd * g1;
          if (dorope) {
            const f32x4 cs0 = *(const f32x4*)(rp + (4 * bj) * 2), cs1 = *(const f32x4*)(rp + (4 * bj + 2) * 2);
            const f32x4 cc = {cs0[0], cs0[2], cs1[0], cs1[2]}, sn = {cs0[1], cs0[3], cs1[1], cs1[3]};
            const f32x4 r0 = y0 * cc - y1 * sn, r1 = y1 * cc + y0 * sn; y0 = r0; y1 = r1;
          }
          const unsigned p0 = pk4_fp8(y0[0], y0[1], y0[2], y0[3]), p1 = pk4_fp8(y1[0], y1[1], y1[2], y1[3]);
          if (bj == 0) { w.x = p0; w.z = p1; } else { w.y = p0; w.w = p1; }
        }
        if (isq) *(u32x4*)(Q + ((size_t)(((b * NH + hh) * 2 + comp) * SEQ + pos) * 64 + fq1 * 32 + fq0 * 16)) = w;
        else *(u32x4*)(Kt + ((size_t)((b * NH + hh) * NKT + (pos >> 6)) * 8192 + comp * 4096 + ((pos >> 5) & 1) * 2048 + fq0 * 1024 + fq1 * 512 + (pos & 31) * 16)) = w;
      }
  }
};
struct EpiVt { static constexpr bool STAGED = false;
  unsigned char* Vt;
  DI void operator()(const f32x4 (&acc)[2][2][4][2], const Unit& u, int wr, int wc, int fr_, int fq_) const {
    int fr = fr_, fq = fq_; asm volatile("" : "+v"(fr), "+v"(fq));
    const int pmv = u.i0, pn = u.i1;
    const int b = pn / 33, pt = pn % 33;
    const int tile = pt * 4 + wc, c = fq >> 1, hi = fq & 1;
#pragma unroll
    for (int ai = 0; ai < 2; ++ai)
#pragma unroll
      for (int m = 0; m < 4; ++m) {
        const int head = 2 * pmv + ai, v = 64 * wr + 16 * m + fr, vb = v >> 5, vv = v & 31;
        const f32x4 a0 = acc[ai][0][m][0], a1 = acc[ai][0][m][1], a2 = acc[ai][1][m][0], a3 = acc[ai][1][m][1];
        u32x4 w; w.x = pk4_fp8(16.f * a0[0], 16.f * a0[1], 16.f * a0[2], 16.f * a0[3]); w.y = pk4_fp8(16.f * a1[0], 16.f * a1[1], 16.f * a1[2], 16.f * a1[3]);
        w.z = pk4_fp8(16.f * a2[0], 16.f * a2[1], 16.f * a2[2], 16.f * a2[3]); w.w = pk4_fp8(16.f * a3[0], 16.f * a3[1], 16.f * a3[2], 16.f * a3[3]);
        *(u32x4*)(Vt + ((size_t)((b * NH + head) * NKT + tile) * 8192 + vb * 2048 + c * 1024 + hi * 512 + vv * 16)) = w;
      }
  }
};
template <bool RES_F32>
struct EpiResid { static constexpr bool STAGED = false;
  const float* resf; bf16_t* xr; const float* gate; float* rowss;
  DI void operator()(const f32x4 (&acc)[2][2][4][2], const Unit& u, int wr, int wc, int fr_, int fq_) const {
    int fr = fr_, fq = fq_; asm volatile("" : "+v"(fr), "+v"(fq));
    const int pm = u.i0, pn = u.i1, b = pm / 32;
    const int col0 = pn * 256 + wc * 32 + 8 * fq;
    f32x4 gv[2][2];
#pragma unroll
    for (int bj = 0; bj < 2; ++bj)
#pragma unroll
      for (int n = 0; n < 2; ++n) gv[bj][n] = *(const f32x4*)(gate + b * 6144 + col0 + bj * 128 + n * 4);
    constexpr int DP = RES_F32 ? 2 : 4;
    u32x4 nx[DP][2][2];
#define ER_LOAD(it_) do { const int row_ = pm * 256 + ((it_) >> 2) * 128 + wr * 64 + ((it_) & 3) * 16 + fr; const size_t off_ = (size_t)row_ * D + col0; \
      _Pragma("unroll") for (int bj = 0; bj < 2; ++bj) { \
        if (RES_F32) { nx[(it_) % DP][bj][0] = *(const u32x4*)(resf + off_ + bj * 128); nx[(it_) % DP][bj][1] = *(const u32x4*)(resf + off_ + bj * 128 + 4); } \
        else nx[(it_) % DP][bj][0] = *(const u32x4*)(xr + off_ + bj * 128); } } while (0)
    ER_LOAD(0); ER_LOAD(1); if (DP == 4) { ER_LOAD(2); ER_LOAD(3); }
    __builtin_amdgcn_sched_barrier(0);
#pragma unroll
    for (int it = 0; it < 8; ++it) { const int ai = it >> 2, m = it & 3;
        const int row = pm * 256 + ai * 128 + wr * 64 + m * 16 + fr;
        const size_t off = (size_t)row * D + col0;
        float ss = 0.f;
        u32x4 cu[2][2];
#pragma unroll
        for (int bj = 0; bj < 2; ++bj) { cu[bj][0] = nx[it % DP][bj][0]; cu[bj][1] = nx[it % DP][bj][1]; }
        if (it + DP < 8) { ER_LOAD(it + DP); __builtin_amdgcn_sched_barrier(0); }
#pragma unroll
        for (int bj = 0; bj < 2; ++bj) {
          f32x4 r0, r1;
          if (RES_F32) { r0 = __builtin_bit_cast(f32x4, cu[bj][0]); r1 = __builtin_bit_cast(f32x4, cu[bj][1]); }
          else { const u32x4 w = cu[bj][0];
            r0 = (f32x4){__uint_as_float(w.x << 16), __uint_as_float(w.x & 0xffff0000u), __uint_as_float(w.y << 16), __uint_as_float(w.y & 0xffff0000u)};
            r1 = (f32x4){__uint_as_float(w.z << 16), __uint_as_float(w.z & 0xffff0000u), __uint_as_float(w.w << 16), __uint_as_float(w.w & 0xffff0000u)}; }
          const f32x4 o0 = r0 + gv[bj][0] * acc[ai][bj][m][0], o1 = r1 + gv[bj][1] * acc[ai][bj][m][1];
          u32x4 w; w.x = cvtpk(o0[0], o0[1]); w.y = cvtpk(o0[2], o0[3]); w.z = cvtpk(o1[0], o1[1]); w.w = cvtpk(o1[2], o1[3]);
          *(u32x4*)(xr + off + bj * 128) = w;
          ss += (o0[0] * o0[0] + o0[1] * o0[1]) + (o0[2] * o0[2] + o0[3] * o0[3]) + (o1[0] * o1[0] + o1[1] * o1[1]) + (o1[2] * o1[2] + o1[3] * o1[3]); }
        ss += __shfl_xor(ss, 16); ss += __shfl_xor(ss, 32);
        if (fq == 0) rowss[(size_t)row * 16 + 4 * pn + wc] = ss;
      }
#undef ER_LOAD
  }
};
struct EpiBf16 { static constexpr bool STAGED = false;
  bf16_t* O; int ldc; const float* scale; int colbase;
  DI void operator()(const f32x4 (&acc)[2][2][4][2], const Unit& u, int wr, int wc, int fr_, int fq_) const {
    int fr = fr_, fq = fq_; asm volatile("" : "+v"(fr), "+v"(fq));
    const int pm = u.i0, pn = u.i1;
    const int col0 = colbase + pn * 256 + wc * 32 + 8 * fq;
    f32x4 sv[2][2];
#pragma unroll
    for (int bj = 0; bj < 2; ++bj)
#pragma unroll
      for (int n = 0; n < 2; ++n) sv[bj][n] = scale ? *(const f32x4*)(scale + col0 + bj * 128 + 4 * n) : (f32x4){1.f, 1.f, 1.f, 1.f};
#pragma unroll
    for (int ai = 0; ai < 2; ++ai)
#pragma unroll
      for (int m = 0; m < 4; ++m) {
        bf16_t* rowp = O + (size_t)(pm * 256 + ai * 128 + wr * 64 + m * 16 + fr) * ldc + col0;
#pragma unroll
        for (int bj = 0; bj < 2; ++bj) { const f32x4 v0 = acc[ai][bj][m][0] * sv[bj][0], v1 = acc[ai][bj][m][1] * sv[bj][1];
          u32x4 w; w.x = cvtpk(v0[0], v0[1]); w.y = cvtpk(v0[2], v0[3]); w.z = cvtpk(v1[0], v1[1]); w.w = cvtpk(v1[2], v1[3]);
          *(u32x4*)(rowp + bj * 128) = w; }
      }
  }
};
struct EpiW8 { static constexpr bool STAGED = false;
  unsigned char* O; int ldc; float mul;
  DI void operator()(const f32x4 (&acc)[2][2][4][2], const Unit& u, int wr, int wc, int fr_, int fq_) const {
    int fr = fr_, fq = fq_; asm volatile("" : "+v"(fr), "+v"(fq));
    const int pm = u.i0, pn = u.i1;
    const int col0 = pn * 256 + wc * 32 + 8 * fq;
#pragma unroll
    for (int ai = 0; ai < 2; ++ai)
#pragma unroll
      for (int m = 0; m < 4; ++m) {
        unsigned char* rowp = O + (size_t)(pm * 256 + ai * 128 + wr * 64 + m * 16 + fr) * ldc + col0;
#pragma unroll
        for (int bj = 0; bj < 2; ++bj) { const f32x4 v0 = acc[ai][bj][m][0] * mul, v1 = acc[ai][bj][m][1] * mul;
          u32x2 w; w.x = pk4_fp8(v0[0], v0[1], v0[2], v0[3]); w.y = pk4_fp8(v1[0], v1[1], v1[2], v1[3]);
          *(u32x2*)(rowp + bj * 128) = w; }
      }
  }
};
struct EpiAct { static constexpr bool STAGED = false;
  bf16_t* act;
  DI void operator()(const f32x4 (&acc)[2][2][4][2], const Unit& u, int wr, int wc, int fr_, int fq_) const {
    int fr = fr_, fq = fq_; asm volatile("" : "+v"(fr), "+v"(fq));
    const int slot0 = u.i0, nvalid = u.i1, pn = u.i2 & 3;
    const int col0 = pn * 128 + wc * 32 + 8 * fq;
#pragma unroll
    for (int ai = 0; ai < 2; ++ai)
#pragma unroll
      for (int m = 0; m < 4; ++m) {
        const int r = ai * 128 + wr * 64 + m * 16 + fr;
        float o[8];
#pragma unroll
        for (int n = 0; n < 2; ++n)
#pragma unroll
          for (int i = 0; i < 4; ++i) { const float g = acc[ai][0][m][n][i], uu = acc[ai][1][m][n][i]; o[4 * n + i] = silu_f(g) * uu; }
        if (r < nvalid) { u32x2 w; w.x = pk4_fp8(o[0], o[1], o[2], o[3]); w.y = pk4_fp8(o[4], o[5], o[6], o[7]);
          *(u32x2*)((unsigned char*)act + (size_t)(slot0 + r) * DE + col0) = w; }
      }
  }
};
struct EpiY { static constexpr bool STAGED = false;
  unsigned char* y; const LAS float* gl;
  DI void operator()(const f32x4 (&acc)[2][2][4][2], const Unit& u, int wr, int wc, int fr_, int fq_) const {
    int fr = fr_, fq = fq_; asm volatile("" : "+v"(fr), "+v"(fq));
    const int slot0 = u.i0, nvalid = u.i1, pn = u.i2 & 3; const LAS float* g = gl + (u.i2 >> 2) * 256;
    const int col0 = pn * 256 + wc * 32 + 8 * fq;
    float gt[2][4];
#pragma unroll
    for (int ai = 0; ai < 2; ++ai)
#pragma unroll
      for (int m = 0; m < 4; ++m) { const int r = ai * 128 + wr * 64 + m * 16 + fr; gt[ai][m] = 16.0f * g[r < nvalid ? r : 0]; }
#pragma unroll
    for (int ai = 0; ai < 2; ++ai)
#pragma unroll
      for (int m = 0; m < 4; ++m) {
        const int r = ai * 128 + wr * 64 + m * 16 + fr;
        if (r < nvalid) {
          unsigned char* rowp = y + (size_t)(slot0 + r) * D + col0;
#pragma unroll
          for (int bj = 0; bj < 2; ++bj) { const f32x4 v0 = acc[ai][bj][m][0] * gt[ai][m], v1 = acc[ai][bj][m][1] * gt[ai][m];
            u32x2 w; w.x = pk4_fp8(v0[0], v0[1], v0[2], v0[3]); w.y = pk4_fp8(v1[0], v1[1], v1[2], v1[3]);
            *(u32x2*)(rowp + bj * 128) = w; }
        }
      }
  }
};

struct SchedGrid {
  const char* A0; const char* B0; size_t astep, bstep; int nM, nN, acol; Deal dl;
  DI void init(const void* A, const void* B, int lda, int ldb, int nM_, int nN_, int acol_ = 0) { A0 = (const char*)A; B0 = (const char*)B; astep = (size_t)256 * lda; bstep = (size_t)256 * ldb; nM = nM_; nN = nN_; acol = acol_; dl.init(nM_ * nN_); }
  DI bool next(int i, Unit& u) const { const int id = dl.id(i); if (id < 0) return false;
    const int grp = 8 * nN, gi = id / grp, fm = gi * 8, gsz = (nM - fm) < 8 ? (nM - fm) : 8; const int pm = fm + (id % grp) % gsz, pn = (id % grp) / gsz;
    u.A = A0 + pm * astep + pn * acol; u.B = B0 + pn * bstep; u.i0 = pm; u.i1 = pn; u.i2 = 0; u.i3 = 0; return true; }
  DI int arow(const Unit&, int r) const { return r; }
};
constexpr int QKV_GEMM_PER_XCD = 25;
struct SchedQKV {
  const char* H; const char* Wqk; const char* Wv; Deal dl;
  DI void init(const void* hcat, const void* wqk, const void* wv) { H = (const char*)hcat; Wqk = (const char*)wqk; Wv = (const char*)wv; dl.init(1584); }
  DI bool next(int i, Unit& u) const { if (dl.j >= QKV_GEMM_PER_XCD) return false; const int t = dl.j + i * QKV_GEMM_PER_XCD; if (t >= 198) return false;
    if (t < 132) { const int id = dl.x * 132 + t; const int gi = id >> 6, fm = gi * 8, gsz = (132 - fm) < 8 ? (132 - fm) : 8; const int pm = fm + (id & 63) % gsz, pn = (id & 63) / gsz;
      u.A = H + (size_t)pm * 256 * 1024; u.B = Wqk + (size_t)pn * 256 * 1024; u.i0 = pm; u.i1 = pn; u.i2 = 0; u.i3 = 0; }
    else { const int id = dl.x * 66 + (t - 132); const int pm = id & 3, pn = id >> 2;
      u.A = Wv + (size_t)pm * 256 * 1024; u.B = H + (size_t)pn * 256 * 1024; u.i0 = pm; u.i1 = pn; u.i2 = 1; u.i3 = 0; }
    return true; }
  DI int arow(const Unit&, int r) const { return r; }
  DI bool bkind(const Unit& u) const { return u.i2 != 0; }
};
struct SchedFold {
  const char* A0; const char* B0; Deal dl;
  DI void init(const void* wpo, const void* wpg) { A0 = (const char*)wpo; B0 = (const char*)wpg; dl.init(1584); }
  DI bool next(int i, Unit& u) const { if (i > 0 || dl.j < QKV_GEMM_PER_XCD) return false;
    const int id = dl.x * (dl.per() - QKV_GEMM_PER_XCD) + (dl.j - QKV_GEMM_PER_XCD); if (id >= 16) return false;
    const int pm = id & 3, g = id >> 2;
    u.A = A0 + (size_t)pm * 256 * 2048 + g * 512; u.B = B0 + (size_t)g * 256 * 512; u.i0 = pm; u.i1 = g; u.i2 = 0; u.i3 = 0; return true; }
  DI int arow(const Unit&, int r) const { return r; }
};
struct EpiQKV { static constexpr bool STAGED = false; EpiQK q; EpiVt v;
  DI void operator()(const f32x4 (&acc)[2][2][4][2], const Unit& u, int wr, int wc, int fr, int fq) const { if (u.i2 == 0) q(acc, u, wr, wc, fr, fq); else v(acc, u, wr, wc, fr, fq); }
};
template <bool GA, int WSTEP_E, int WSTEP_PN, int LDA>
struct SchedMoe {
  const LAS int* T; const char* A0; const char* W0; const int* tok; const LAS int* tokl; Deal dl;
  DI bool next(int i, Unit& u) const { const int id = dl.id(i); if (id < 0) return false;
    const int tile = id >> 2, pn = id & 3; const int e = T[128 + tile];
    const int j = tile - T[e], cnt = T[66 + e], slot0 = T[33 + e] + 256 * j, nv = cnt - 256 * j;
    u.A = GA ? A0 : A0 + (size_t)slot0 * LDA; u.B = W0 + (size_t)e * WSTEP_E + pn * WSTEP_PN;
    u.i0 = slot0; u.i1 = nv < 256 ? nv : 256; u.i2 = pn | (i << 2); u.i3 = e * 32768 + 256 * j; return true; }
  DI int arow(const Unit& u, int r) const { return r < u.i1 ? tokl[(u.i2 >> 2) * 256 + r] : 0; }
};

DI void phase_mods(const Params& p, LAS unsigned char* lds) {
  float* sm = (float*)(WSP + WS_SMALL);
  LAS float* sc = (LAS float*)lds;
  LAS float* red = sc + 5 * 1024;
  const int tid = opaque_tid();
  for (int i = tid; i < 5 * 1024; i += 512) { const float v = (i < 4096) ? p.c[i] : p.c_ctx[i - 4096]; sc[i] = silu_f(v); }
  __syncthreads();
  for (int it = blockIdx.x; it < 192; it += gridDim.x) {
    const int l = it / 96, col = (it % 96) * 64 + (tid & 63), ks = tid >> 6;
    const float* w = p.ada_w + (size_t)l * D * 6144 + col;
    float a0 = 0.f, a1 = 0.f, a2 = 0.f, a3 = 0.f, a4 = 0.f;
    for (int k0 = ks * 128; k0 < ks * 128 + 128; k0 += 32) {
      float wv[32];
#pragma unroll
      for (int u = 0; u < 32; ++u) wv[u] = w[(size_t)(k0 + u) * 6144];
#pragma unroll
      for (int u = 0; u < 32; ++u) { const int k = k0 + u; a0 += sc[k] * wv[u]; a1 += sc[1024 + k] * wv[u]; a2 += sc[2048 + k] * wv[u]; a3 += sc[3072 + k] * wv[u]; a4 += sc[4096 + k] * wv[u]; } }
    LAS float* r = red + (ks * 64 + (tid & 63)) * 5; r[0] = a0; r[1] = a1; r[2] = a2; r[3] = a3; r[4] = a4;
    __syncthreads();
    if (tid < 320) { const int cc = tid & 63, bb = tid >> 6; float s = 0.f;
#pragma unroll
      for (int k = 0; k < 8; ++k) s += red[(k * 64 + cc) * 5 + bb];
      const int c2 = (it % 96) * 64 + cc; s += p.ada_b[l * 6144 + c2];
      if (bb < 4) sm[SM_MOD + (l * 4 + bb) * 6144 + c2] = s; else if (l == 0 && c2 < 2048) sm[SM_MODC + c2] = s; }
    __syncthreads();
  }
  if (blockIdx.x == gridDim.x - 1) {
    if (tid < 64) {
      float a = p.lq1[tid] * p.lk1[tid], b = p.lq2[tid] * p.lk2[tid]; a = wave_sum(a); b = wave_sum(b);
      float mq = fabsf(p.qg[tid]), mk = fabsf(p.kg[tid]);
#pragma unroll
      for (int o = 1; o < 64; o <<= 1) { mq = fmaxf(mq, __shfl_xor(mq, o)); mk = fmaxf(mk, __shfl_xor(mk, o)); }
      if (tid == 0) { sm[SM_SCAL + 0] = __expf(a) - __expf(b) + 0.2f; sm[SM_SCAL + 1] = -(8.0f * mq * mk * LOG2E + 0.01f); }
    }
    for (int i = tid; i < 2048; i += 512) { const int pos = i >> 4, f = i & 15; const float inv = powf(10000.0f, -(float)f / 16.0f); const float ang = (float)pos * inv; float s, c; sincosf(ang, &s, &c);
      sm[SM_ROPE + i * 2] = c; sm[SM_ROPE + i * 2 + 1] = s; }
  }
}
template <bool F8>
DI void transpose_item_t(const float* W, int ldn, int K, void* WTv, int k0, int n0, int drow0, LAS float* scr, int lane, const float* ksc = nullptr) {
  f32x4 v[8];
#pragma unroll
  for (int i = 0; i < 8; ++i) v[i] = *(const f32x4*)(W + (size_t)(k0 + 8 * i + (lane >> 3)) * ldn + n0 + 4 * (lane & 7));
#pragma unroll
  for (int i = 0; i < 8; ++i) { LAS float* d = scr + (8 * i + (lane >> 3)) * 33 + 4 * (lane & 7); d[0] = v[i][0]; d[1] = v[i][1]; d[2] = v[i][2]; d[3] = v[i][3]; }
  asm volatile("s_waitcnt lgkmcnt(0)" ::: "memory");
  const int c = lane & 7;
#pragma unroll
  for (int j = 0; j < 4; ++j) { const int n = (lane >> 3) + 8 * j; const LAS float* s = scr + (8 * c) * 33 + n;
    if constexpr (F8) { u32x2 o; o.x = pk4_fp8(32.f * s[0 * 33], 32.f * s[1 * 33], 32.f * s[2 * 33], 32.f * s[3 * 33]); o.y = pk4_fp8(32.f * s[4 * 33], 32.f * s[5 * 33], 32.f * s[6 * 33], 32.f * s[7 * 33]);
      *(u32x2*)((unsigned char*)WTv + (size_t)(drow0 + n) * K + k0 + 8 * c) = o; }
    else { f32x4 m0 = {1.f, 1.f, 1.f, 1.f}, m1 = m0; if (ksc) { m0 = *(const f32x4*)(ksc + k0 + 8 * c); m1 = *(const f32x4*)(ksc + k0 + 8 * c + 4); }
      u32x4 o; o.x = cvtpk(s[0 * 33] * m0[0], s[1 * 33] * m0[1]); o.y = cvtpk(s[2 * 33] * m0[2], s[3 * 33] * m0[3]); o.z = cvtpk(s[4 * 33] * m1[0], s[5 * 33] * m1[1]); o.w = cvtpk(s[6 * 33] * m1[2], s[7 * 33] * m1[3]);
      *(u32x4*)((bf16_t*)WTv + (size_t)(drow0 + n) * K + k0 + 8 * c) = o; } }
  asm volatile("s_waitcnt lgkmcnt(0)" ::: "memory");
}
DI void transpose_item(const float* W, int ldn, int K, bf16_t* WT, int k0, int n0, int drow0, LAS float* scr, int lane) { transpose_item_t<false>(W, ldn, K, WT, k0, n0, drow0, scr, lane); }
DI void phase_weights_small(const Params& p, LAS unsigned char* lds) {
  const int tid = opaque_tid(), lane = tid & 63, wave = tid >> 6;
  LAS float* scr = (LAS float*)(lds + wave * 16384);
  const int gw = blockIdx.x * 8 + wave, NGW = gridDim.x * 8;
  unsigned char* ws = WSP;
  constexpr int I_QK = 16 * 64, I_V = 16 * 32, I_SQ = 16 * 32, I_PG = 4 * 4 * 8, I_R = 16 * 1;
  constexpr int I_SMALL = I_QK + I_V + 3 * I_SQ + I_PG + I_R;
  for (int it = gw; it < I_SMALL; it += NGW) {
    int r = it;
    if (r < I_QK) { const int kb = r / 64, nb = r % 64; transpose_item_t<true>(p.w_in, 3072, 1024, ws + WS_WQK, 64 * kb, 32 * nb, 32 * nb, scr, lane); continue; } r -= I_QK;
    if (r < I_V) { const int kb = r / 32, nb = r % 32; transpose_item_t<true>(p.w_in + 2048, 3072, 1024, ws + WS_WV, 64 * kb, 32 * nb, 32 * nb, scr, lane); continue; } r -= I_V;
    if (r < I_SQ) { const int kb = r / 32, nb = r % 32; transpose_item_t<true>(p.w_out, 1024, 1024, ws + WS_WO, 64 * kb, 32 * nb, 32 * nb, scr, lane); continue; } r -= I_SQ;
    if (r < I_SQ) { const int kb = r / 32, nb = r % 32; transpose_item_t<true>(p.pw_in, 1024, 1024, ws + WS_WPI, 64 * kb, 32 * nb, 32 * nb, scr, lane); continue; } r -= I_SQ;
    if (r < I_SQ) { const int kb = r / 32, nb = r % 32; transpose_item_t<false>(p.pw_out, 1024, 1024, ws + WS_WPO, 64 * kb, 32 * nb, 32 * nb, scr, lane, p.pscale); continue; } r -= I_SQ;
    if (r < I_PG) { const float* src = p.pw_g + (size_t)r * 2048; bf16_t* dst = (bf16_t*)(ws + WS_WPG) + (size_t)r * 2048;
#pragma unroll
      for (int q = 0; q < 8; ++q) { const f32x4 v = *(const f32x4*)(src + q * 256 + lane * 4); u32x2 o; o.x = cvtpk(v[0], v[1]); o.y = cvtpk(v[2], v[3]); *(u32x2*)(dst + q * 256 + lane * 4) = o; }
      continue; } r -= I_PG;
    transpose_item(p.rw, 32, 1024, (bf16_t*)(ws + WS_WR), 64 * r, 0, 0, scr, lane);
  }
}
constexpr int LDS_TAB_OFF = 131072;
DI void phase_weights_moe(const Params& p, LAS unsigned char* lds) {
  const int tid = opaque_tid(), lane = tid & 63, wave = tid >> 6;
  LAS float* scr = (LAS float*)(lds + wave * 16384);
  volatile LAS unsigned* qs = (volatile LAS unsigned*)(lds + LDS_TAB_OFF + 1024);
  unsigned char* ws = WSP; unsigned* ctr = (unsigned*)(ws + WS_CTL) + CW_WQ;
  constexpr int I_GU = 2 * 32 * 16 * 16  , I_D = 2 * 32 * 8 * 32;
  constexpr int NIT = 2 * I_GU + I_D, CHW = 32;
  static_assert(NIT % CHW == 0, "whole chunks");
  for (int it = 0;; ++it) {
    if (tid == 0) qs[it & 1] = __hip_atomic_fetch_add(ctr, 1u, __ATOMIC_RELAXED, __HIP_MEMORY_SCOPE_AGENT);
    __syncthreads();
    const unsigned c0 = (unsigned)__builtin_amdgcn_readfirstlane((int)qs[it & 1]);
    if ((int)c0 * CHW >= NIT) break;
    for (int k = 0; k < 4; ++k) { int r = (int)c0 * CHW + wave * 4 + k;
      if (r < 2 * I_GU) { const int up = r / I_GU; r %= I_GU; const int le = r / 256, q = r % 256, kb = q / 16, nb = q % 16;
        const float* src = (up ? p.wu : p.wg) + (size_t)le * 1024 * 512; const int n0 = 32 * nb;
        transpose_item_t<true>(src, 512, 1024, ws + WS_WGU + (size_t)le * 1024 * 1024, 64 * kb, n0, 256 * (n0 >> 7) + 128 * up + (n0 & 127), scr, lane); continue; } r -= 2 * I_GU;
      { const int le = r / 256, q = r % 256, kb = q / 32, nb = q % 32;
        transpose_item_t<true>(p.wd + (size_t)le * 512 * 1024, 1024, 512, ws + WS_WD + (size_t)le * 1024 * 512, 64 * kb, 32 * nb, 32 * nb, scr, lane); } }
  }
}
DI void norm_mod_row(const float* xr, const float* g, const float* shift, const float* scale, unsigned char* orow, int lane) {
  f32x4 v[4]; float s = 0.f;
#pragma unroll
  for (int j = 0; j < 4; ++j) { v[j] = *(const f32x4*)(xr + 4 * lane + 256 * j); s += (v[j][0] * v[j][0] + v[j][1] * v[j][1]) + (v[j][2] * v[j][2] + v[j][3] * v[j][3]); }
  const float rstd = rsqrtf(wave_sum(s) * (1.f / D) + EPS);
#pragma unroll
  for (int j = 0; j < 4; ++j) { const int c = 4 * lane + 256 * j; const f32x4 gg = *(const f32x4*)(g + c), sh = *(const f32x4*)(shift + c), sc = *(const f32x4*)(scale + c);
    const f32x4 y = v[j] * rstd * gg * (sc + 1.0f) + sh; *(unsigned*)(orow + c) = pk4_fp8(y[0], y[1], y[2], y[3]); }
}
DI void phase_hcat(const Params& p) {
  const float* sm = (const float*)(WSP + WS_SMALL); unsigned char* hcat = WSP + WS_R0;
  const int tid = opaque_tid(), lane = tid & 63, gw = blockIdx.x * 8 + (tid >> 6), NGW = gridDim.x * 8;
  for (int r0 = gw; r0 < NROWS; r0 += 4 * NGW) {
    f32x4 v[4][4]; const float* shp[4]; int rr[4];
#pragma unroll
    for (int q = 0; q < 4; ++q) { const int r = r0 + q * NGW; rr[q] = r; const int rc = r < NROWS ? r : r0; const int b = rc / KV, t = rc % KV;
      const float* xr = (t < SEQ) ? p.x + (size_t)(b * SEQ + t) * D : p.ctx + (size_t)(b * CTXL + t - SEQ) * D;
      shp[q] = (t < SEQ) ? sm + SM_MOD + b * 6144 : sm + SM_MODC;
#pragma unroll
      for (int j = 0; j < 4; ++j) v[q][j] = *(const f32x4*)(xr + 4 * lane + 256 * j); }
#pragma unroll
    for (int q = 0; q < 4; ++q) { float s = 0.f;
#pragma unroll
      for (int j = 0; j < 4; ++j) s += (v[q][j][0] * v[q][j][0] + v[q][j][1] * v[q][j][1]) + (v[q][j][2] * v[q][j][2] + v[q][j][3] * v[q][j][3]);
      const float rstd = rsqrtf(wave_sum(s) * (1.f / D) + EPS);
      if (rr[q] < NROWS) {
#pragma unroll
        for (int j = 0; j < 4; ++j) { const int c = 4 * lane + 256 * j; const f32x4 gg = *(const f32x4*)(p.n1g + c), sh = *(const f32x4*)(shp[q] + c), sc = *(const f32x4*)(shp[q] + 1024 + c);
          const f32x4 y = v[q][j] * rstd * gg * (sc + 1.0f) + sh; *(unsigned*)(hcat + (size_t)rr[q] * D + c) = pk4_fp8(y[0], y[1], y[2], y[3]); } } }
  }
}
namespace att {
constexpr int SLOT = 8192, LDS_K = 0, LDS_V = 3 * SLOT, NT = NKT;
typedef const LAS char* lptr;
DI void glds16(const void* gsrc, unsigned lds_dst) { unsigned keep;
  asm volatile("s_mov_b32 %0, m0\n\ts_mov_b32 m0, %2\n\ts_nop 0\n\tglobal_load_lds_dwordx4 %1, off\n\ts_mov_b32 m0, %0" : "=&s"(keep) : "v"(gsrc), "s"(lds_dst) : "memory"); }
DI u32x4 ldsrdu(lptr p) { return *(const LAS u32x4*)p; }
DI float max3f(float a, float b, float c) { float d; asm("v_max3_f32 %0, %1, %2, %3" : "=v"(d) : "v"(a), "v"(b), "v"(c)); return d; }
DI int pk4s(float a, float b, float c, float d, float sc) { int r;
  asm("v_cvt_scalef32_pk_fp8_f32 %0, %1, %2, %3" : "=v"(r) : "v"(a), "v"(b), "v"(sc));
  asm("v_cvt_scalef32_pk_fp8_f32 %0, %1, %2, %3 op_sel:[0,0,0,1]" : "+v"(r) : "v"(c), "v"(d), "v"(sc)); return r; }
#define AT_WAIT_BAR(N) asm volatile("s_waitcnt vmcnt(" #N ") lgkmcnt(0)\n\ts_barrier" ::: "memory")
#define AT_SBAR() __builtin_amdgcn_sched_barrier(0)
#define AT_EX(v) __builtin_amdgcn_exp2f(v)
#define AT_CAT2(lo, hi) __builtin_bit_cast(v8i_t, __builtin_shufflevector((lo), (hi), 0, 1, 2, 3, 4, 5, 6, 7))
#define AT_MFMA8(acc, va, pb, sa, sb) asm volatile("v_mfma_scale_f32_32x32x64_f8f6f4 %0, %1, %2, %0, %3, %4 op_sel_hi:[0,0,0]" : "+v"(acc) : "v"(va), "v"(pb), "v"(sa), "v"(sb))
#define AT_QK8(c, ka, qb_) asm volatile("v_mfma_scale_f32_32x32x64_f8f6f4 %0, %1, %2, 0, %3, %4 op_sel_hi:[0,0,0]" : "=&v"(c) : "v"(ka), "v"(qb_), "v"(sck), "v"(scq))

DI void attn_unit(const char* Kt, const char* Vt, const unsigned char* Q, unsigned char* AO, const float* subg, LAS unsigned char* lds, int b, int h, int qb, float lam, int smul, int sadd) {
  const int tid = opaque_tid(), lane = tid & 63, r32 = lane & 31, hi = lane >> 5;
  const int wid = __builtin_amdgcn_readfirstlane(tid >> 6), comp = wid >> 2, wq = wid & 3;
  const int q0 = qb * 128 + wq * 32;
  const char* ksrc = Kt + (size_t)(b * NH + h) * NT * 8192 + wid * 1024 + lane * 16;
  const char* vsrc = Vt + (size_t)(b * NH + h) * NT * 8192 + wid * 1024 + lane * 16;
  const unsigned lds0 = (unsigned)(size_t)lds;
  const unsigned kdst = lds0 + LDS_K + wid * 1024, vdst = lds0 + LDS_V + wid * 1024;
#define DMA_K(t, slot) glds16(ksrc + (size_t)(t) * 8192, (unsigned)__builtin_amdgcn_readfirstlane(kdst + (slot)))
#define DMA_V(t, slot) glds16(vsrc + (size_t)(t) * 8192, (unsigned)__builtin_amdgcn_readfirstlane(vdst + (slot)))
  const lptr kp0 = (lptr)lds + LDS_K + comp * 4096 + hi * 512 + r32 * 16;
  const lptr vp0 = (lptr)lds + LDS_V + hi * 512 + r32 * 16;
  DMA_K(0, 0); DMA_V(0, 0); DMA_K(1, SLOT);
  v8i_t q8;
  { const unsigned char* Qw = Q + (size_t)(((b * NH + h) * 2 + comp) * SEQ + q0 + r32) * 64 + hi * 32;
    q8 = AT_CAT2(*(const u32x4*)Qw, *(const u32x4*)(Qw + 16)); }
  DMA_K(2, 2 * SLOT);
  f32x16 o[4], ol;
  v8i_t ones8 = {0x38383838, 0x38383838, 0x38383838, 0x38383838, 0x38383838, 0x38383838, 0x38383838, 0x38383838};
  asm volatile("" : "+v"(ones8));
#pragma unroll
  for (int r = 0; r < 16; ++r) { o[0][r] = 0.f; o[1][r] = 0.f; o[2][r] = 0.f; o[3][r] = 0.f; ol[r] = 0.f; }
  v8i_t kf[2]; u32x4 vlo[4], vhi[4];
  f32x16 pA0, pA1, pB0, pB1; v8i_t pq;
  int psc = 127; float pscf = 1.0f; int sca = 123, sck = 127, scq = 124, sc1 = 127;
  asm volatile("" : "+v"(sca), "+v"(sck), "+v"(scq), "+v"(sc1));
#define SETSC(smax) do { psc = (int)__builtin_floorf(smax) + 120; pscf = __builtin_bit_cast(float, ((psc ^ smul) + sadd) << 23); } while (0)
#define KLD(kp_, kb) AT_CAT2(ldsrdu((kp_) + (kb) * 2048), ldsrdu((kp_) + (kb) * 2048 + 1024))
  int sl_prev = 0, sl_cur = 0, sl_next = SLOT;
#define ROT() do { sl_prev = sl_cur; sl_cur = sl_next; sl_next = (sl_next == 2 * SLOT) ? 0 : sl_next + SLOT; } while (0)
  AT_WAIT_BAR(3);
  { kf[0] = KLD(kp0, 0); kf[1] = KLD(kp0, 1);
    AT_QK8(pA0, kf[0], q8); AT_QK8(pA1, kf[1], q8);
    asm volatile("s_nop 15\n\ts_nop 15\n\ts_nop 15\n\ts_nop 15\n\ts_nop 15\n\ts_nop 15\n\ts_nop 15\n\ts_nop 15\n\ts_nop 15" : "+v"(pA0), "+v"(pA1));
    float smx = max3f(pA0[0], pA0[1], pA0[2]);
#pragma unroll
    for (int r = 3; r < 15; r += 2) smx = max3f(smx, pA0[r], pA0[r + 1]);
    smx = __builtin_fmaxf(smx, pA0[15]);
#pragma unroll
    for (int r = 0; r < 16; r += 2) smx = max3f(smx, pA1[r], pA1[r + 1]);
    SETSC(smx);
#pragma unroll
    for (int r = 0; r < 16; ++r) { pA0[r] = AT_EX(pA0[r]); pA1[r] = AT_EX(pA1[r]); } }
  AT_WAIT_BAR(0);
  DMA_K(3, 0); DMA_V(1, SLOT);
  ROT();
  { const lptr kp = kp0 + sl_cur; kf[0] = KLD(kp, 0); kf[1] = KLD(kp, 1); }
  AT_WAIT_BAR(2);
#define PVAL(P0, P1, j) ((j) < 16 ? P0[(j) & 15] : P1[(j) & 15])
#define EXP4(CX, B0) do { \
    smx_ = max3f(smx_, CX[(B0) + 0], CX[(B0) + 1]); smx_ = max3f(smx_, CX[(B0) + 2], CX[(B0) + 3]); \
    { float e0_ = AT_EX(CX[(B0) + 0]), e1_ = AT_EX(CX[(B0) + 1]), e2_ = AT_EX(CX[(B0) + 2]), e3_ = AT_EX(CX[(B0) + 3]); \
      asm volatile("" : "+v"(smx_), "+v"(e0_), "+v"(e1_), "+v"(e2_), "+v"(e3_)); \
      CX[(B0) + 0] = e0_; CX[(B0) + 1] = e1_; CX[(B0) + 2] = e2_; CX[(B0) + 3] = e3_; } } while (0)
#define EXP8(CX, B0) do { EXP4(CX, B0); EXP4(CX, (B0) + 4); } while (0)
#define GAPA(i, C0, C1, P0, P1) do { \
    if ((i) & 1) vhi[(i) >> 1] = ldsrdu(vp_ + ((i) >> 1) * 2048 + 1024); else vlo[(i) >> 1] = ldsrdu(vp_ + ((i) >> 1) * 2048); \
    if ((i) == 0) { AT_QK8(C0, kf[0], q8); } else if ((i) == 4) { AT_QK8(C1, kf[1], q8); } \
    { int w_ = pk4s(PVAL(P0, P1, 4 * (i)), PVAL(P0, P1, 4 * (i) + 1), PVAL(P0, P1, 4 * (i) + 2), PVAL(P0, P1, 4 * (i) + 3), pscf); \
      asm volatile("" : "+v"(w_)); pq[i] = w_; } \
    if ((i) == 6) { EXP4(C0, 0); } else if ((i) == 7) { EXP4(C0, 4); } \
    AT_SBAR(); } while (0)
#define GAPB(g, C0, C1, GL) do { \
    { const v8i_t va_ = AT_CAT2(vlo[g], vhi[g]); AT_MFMA8(o[g], va_, pq, sca, psc); } \
    if ((g) == 3) AT_MFMA8(ol, ones8, pq, sc1, psc); \
    if ((g) == 0) { EXP8(C0, 8); } else if ((g) == 1) { EXP8(C1, 0); } else if ((g) == 2) { EXP8(C1, 8); } \
    if ((GL) && (g) < 2) kf[g] = KLD(kn_, g); \
    AT_SBAR(); } while (0)
#define STEP(C0, C1, P0, P1, t, GK, GV, GL) do { AT_SBAR(); \
    const lptr vp_ = vp0 + sl_prev; const lptr kn_ = kp0 + sl_next; float smx_ = -3.0e38f; \
    GAPA(0, C0, C1, P0, P1); GAPA(1, C0, C1, P0, P1); GAPA(2, C0, C1, P0, P1); GAPA(3, C0, C1, P0, P1); \
    GAPA(4, C0, C1, P0, P1); GAPA(5, C0, C1, P0, P1); GAPA(6, C0, C1, P0, P1); GAPA(7, C0, C1, P0, P1); \
    if (GK) { DMA_K((t) + 3, sl_cur); } if (GV) { DMA_V((t) + 1, sl_next); } \
    AT_SBAR(); \
    GAPB(0, C0, C1, GL); GAPB(1, C0, C1, GL); GAPB(2, C0, C1, GL); GAPB(3, C0, C1, GL); \
    SETSC(smx_); \
  } while (0)
#define ENDW(tt) do { if ((tt) + 3 < NT) { AT_WAIT_BAR(2); } else if ((tt) + 2 < NT) { AT_WAIT_BAR(1); } else { AT_WAIT_BAR(0); } } while (0)
  int t = 1;
  for (; t + 5 < NT; t += 2) {
    STEP(pB0, pB1, pA0, pA1, t, true, true, true);     AT_WAIT_BAR(2); ROT();
    STEP(pA0, pA1, pB0, pB1, t + 1, true, true, true); AT_WAIT_BAR(2); ROT();
  }
  for (; t + 1 < NT; t += 2) {
    STEP(pB0, pB1, pA0, pA1, t, (t + 3 < NT), (t + 1 < NT), (t + 1 < NT));         ENDW(t);     ROT();
    STEP(pA0, pA1, pB0, pB1, t + 1, (t + 4 < NT), (t + 2 < NT), (t + 2 < NT));     ENDW(t + 1); ROT();
  }
  STEP(pB0, pB1, pA0, pA1, NT - 1, false, false, false);
  {
#pragma unroll
    for (int i = 0; i < 4; ++i) { pq[i] = pk4s(pB0[4 * i], pB0[4 * i + 1], pB0[4 * i + 2], pB0[4 * i + 3], pscf); pq[4 + i] = pk4s(pB1[4 * i], pB1[4 * i + 1], pB1[4 * i + 2], pB1[4 * i + 3], pscf); }
    const lptr vp = vp0 + sl_cur;
    asm volatile("s_nop 1" : "+v"(pq));
#pragma unroll
    for (int vb = 0; vb < 4; ++vb) { const v8i_t va_ = AT_CAT2(ldsrdu(vp + vb * 2048), ldsrdu(vp + vb * 2048 + 1024)); AT_MFMA8(o[vb], va_, pq, sca, psc); }
    AT_MFMA8(ol, ones8, pq, sc1, psc);
    asm volatile("s_nop 15\n\ts_nop 15\n\ts_nop 15\n\ts_nop 15\n\ts_nop 15\n\ts_nop 15" : "+v"(o[0]), "+v"(o[1]), "+v"(o[2]), "+v"(o[3]), "+v"(ol) :: "memory"); }
  const float l_reg = ol[0];
  AT_WAIT_BAR(0);
  LAS float* ex = (LAS float*)lds + wq * 4096;
  if (comp == 1) { const float f = lam / l_reg;
#pragma unroll
    for (int vb = 0; vb < 4; ++vb)
#pragma unroll
      for (int r = 0; r < 16; ++r) ex[(vb * 16 + r) * 64 + lane] = o[vb][r] * f; }
  AT_WAIT_BAR(0);
  if (comp == 0) { const float f = 1.0f / l_reg; float ss = 0.f;
#pragma unroll
    for (int vb = 0; vb < 4; ++vb)
#pragma unroll
      for (int r = 0; r < 16; ++r) { const float v = o[vb][r] * f - ex[(vb * 16 + r) * 64 + lane]; o[vb][r] = v; ss += v * v; }
    ss += __shfl_xor(ss, 32);
    const float rstd = rsqrtf(ss * (1.0f / 128.0f) + EPS) * 0.8f;
    LAS unsigned char* stg = lds + 65536 + wq * 4608;
#pragma unroll
    for (int vb = 0; vb < 4; ++vb)
#pragma unroll
      for (int gq = 0; gq < 4; ++gq) { const int v0 = 32 * vb + 8 * gq + 4 * hi; const f32x4 sg = *(const f32x4*)(subg + v0);
        *(LAS unsigned*)(stg + r32 * 144 + v0) = pk4_fp8(o[vb][4 * gq] * rstd * sg[0], o[vb][4 * gq + 1] * rstd * sg[1], o[vb][4 * gq + 2] * rstd * sg[2], o[vb][4 * gq + 3] * rstd * sg[3]); }
    asm volatile("s_waitcnt lgkmcnt(0)" ::: "memory");
    unsigned char* orow = AO + (size_t)(b * SEQ + q0) * D + h * 128;
#pragma unroll
    for (int i = 0; i < 4; ++i) { const int row = i * 8 + (lane >> 3), ch = lane & 7; const u32x4 v = *(const LAS u32x4*)(stg + row * 144 + ch * 16);
      *(u32x4*)(orow + (size_t)row * D + ch * 16) = v; }
  }
  AT_WAIT_BAR(0);
#undef DMA_K
#undef DMA_V
#undef ROT
#undef PVAL
#undef GAPA
#undef GAPB
#undef EXP4
#undef EXP8
#undef STEP
#undef ENDW
#undef SETSC
#undef KLD
}
}
DI void phase_attn(const Params& p, LAS unsigned char* lds) {
  const float* sm = (const float*)(WSP + WS_SMALL);
  const char* Kt = (const char*)(WSP + WS_R2); const char* Vt = (const char*)(WSP + WS_R3); const unsigned char* Q = WSP + WS_R1; unsigned char* AO = WSP + WS_R0;
  const float lam = sm[SM_SCAL + 0];
  float one = 1.0f, four = 4.0f; asm volatile("" : "+v"(one), "+v"(four));
  const int tst = __builtin_amdgcn_readfirstlane(att::pk4s(one, one, one, one, four) & 0xff);
  const int smul = (tst == 0x28) ? 0 : 0xff, sadd = (tst == 0x28) ? 0 : -1;
  const int G = gridDim.x, bx = blockIdx.x; const int vcu = (G % 8 == 0) ? (bx % 8) * (G / 8) + bx / 8 : bx;
  for (int unit = vcu; unit < 2048; unit += G) { const int bh = unit >> 6, qb = unit & 63;
    att::attn_unit(Kt, Vt, Q, AO, p.subg, lds, bh >> 3, bh & 7, qb, lam, smul, sadd); }
}

DI void phase_router(const Params& p, LAS unsigned char* lds, int layer) {
  const float* sm = (const float*)(WSP + WS_SMALL);
  const bf16_t* X = (const bf16_t*)(WSP + WS_XR); bf16_t* h2 = (bf16_t*)(WSP + WS_R1); const bf16_t* Wr = (const bf16_t*)(WSP + WS_WR); const float* rowss = (const float*)(WSP + WS_ROWSS);
  unsigned* cnt = (unsigned*)(WSP + WS_CTL) + CW_CNT + layer * 32 * CW_CNT_STRIDE;
  int* tok_list = (int*)(WSP + WS_LIST); float* gate_list = (float*)(WSP + WS_LIST + 4 * MiB); int* tokslot = (int*)(WSP + WS_TOKSLOT);
  const int tid = opaque_tid(), lane = tid & 63, fr = lane & 15, fq = lane >> 4, wid = tid >> 6;
  constexpr int WPITCH = 2064;
  LAS unsigned char* Wl = lds; LAS float* gsl = (LAS float*)(lds + 66560); LAS float* shl = (LAS float*)(lds + 70656);
  LAS float* lg = (LAS float*)(lds + 74752) + wid * 512;
  LAS int* lcnt = (LAS int*)(lds + 91136); LAS int* gbase = lcnt + 32;
  for (int i = tid; i < 32 * 128; i += 512) { const int e = i >> 7, c = i & 127; *(LAS u32x4*)(Wl + e * WPITCH + c * 16) = *(const u32x4*)(Wr + (size_t)e * D + c * 8); }
  const float* ng = p.n2g + layer * D;
  for (int blk = blockIdx.x; blk < NTOK / 128; blk += gridDim.x) {
    const int b = (blk * 128) / SEQ;
    const float* shp = sm + SM_MOD + (layer * 4 + b) * 6144 + 3 * 1024; const float* scp = shp + 1024;
    __syncthreads();
    for (int i = tid; i < 1024; i += 512) { gsl[i] = ng[i] * (scp[i] + 1.0f); shl[i] = shp[i]; }
    if (tid < 32) lcnt[tid] = 0;
    __syncthreads();
    const int row = blk * 128 + wid * 16 + fr;
    const bf16_t* xr = X + (size_t)row * D + 8 * fq;
    float ss; { const f32x4 q = *(const f32x4*)(rowss + (size_t)row * 16 + 4 * fq); ss = (q[0] + q[1]) + (q[2] + q[3]); }
    ss += __shfl_xor(ss, 16); ss += __shfl_xor(ss, 32);
    const float rstd = rsqrtf(ss * (1.f / D) + EPS);
    f32x4 l0 = {0.f, 0.f, 0.f, 0.f}, l1 = {0.f, 0.f, 0.f, 0.f};
    const LAS unsigned char* w0 = Wl + fr * WPITCH + fq * 16; const LAS unsigned char* w1 = w0 + 16 * WPITCH;
#pragma unroll 8
    for (int kk = 0; kk < 32; ++kk) { const int c0 = 32 * kk + 8 * fq;
      const u32x4 xw = *(const u32x4*)(xr + 32 * kk);
      const f32x4 a = {__uint_as_float(xw.x << 16), __uint_as_float(xw.x & 0xffff0000u), __uint_as_float(xw.y << 16), __uint_as_float(xw.y & 0xffff0000u)};
      const f32x4 c = {__uint_as_float(xw.z << 16), __uint_as_float(xw.z & 0xffff0000u), __uint_as_float(xw.w << 16), __uint_as_float(xw.w & 0xffff0000u)};
      const f32x4 g0 = *(const LAS f32x4*)(gsl + c0), g1 = *(const LAS f32x4*)(gsl + c0 + 4), h0 = *(const LAS f32x4*)(shl + c0), h1 = *(const LAS f32x4*)(shl + c0 + 4);
      const f32x4 y0 = a * rstd * g0 + h0, y1 = c * rstd * g1 + h1;
      u32x4 w; w.x = cvtpk(y0[0], y0[1]); w.y = cvtpk(y0[2], y0[3]); w.z = cvtpk(y1[0], y1[1]); w.w = cvtpk(y1[2], y1[3]);
      { u32x2 q8; q8.x = pk4_fp8(y0[0], y0[1], y0[2], y0[3]); q8.y = pk4_fp8(y1[0], y1[1], y1[2], y1[3]); *(u32x2*)((unsigned char*)h2 + (size_t)row * D + c0) = q8; }
      const bf16x8 af = __builtin_bit_cast(bf16x8, w);
      const bf16x8 b0 = *(const LAS bf16x8*)(w0 + kk * 64), b1 = *(const LAS bf16x8*)(w1 + kk * 64);
      l0 = __builtin_amdgcn_mfma_f32_16x16x32_bf16(af, b0, l0, 0, 0, 0); l1 = __builtin_amdgcn_mfma_f32_16x16x32_bf16(af, b1, l1, 0, 0, 0); }
#pragma unroll
    for (int i = 0; i < 4; ++i) { lg[(4 * fq + i) * 32 + fr] = l0[i]; lg[(4 * fq + i) * 32 + 16 + fr] = l1[i]; }
    asm volatile("s_waitcnt lgkmcnt(0)" ::: "memory");
    int tok = 0, e1 = 0, e2 = 0, r1 = 0, r2 = 0; float g1 = 0.f, g2 = 0.f;
    if (lane < 16) {
      tok = blk * 128 + wid * 16 + lane;
      float pr[32]; float mx = -1e30f;
#pragma unroll
      for (int e = 0; e < 32; ++e) { pr[e] = lg[lane * 32 + e] + p.rb[e]; mx = fmaxf(mx, pr[e]); }
      float sum = 0.f;
#pragma unroll
      for (int e = 0; e < 32; ++e) { pr[e] = __expf(pr[e] - mx); sum += pr[e]; }
      const float inv = 1.0f / sum;
      float best = -1.f; int gsel = 0;
#pragma unroll
      for (int g = 0; g < 4; ++g) { float m1 = -1.f, m2 = -1.f;
#pragma unroll
        for (int k = 0; k < 8; ++k) { const float v = pr[g * 8 + k] * inv; if (v > m1) { m2 = m1; m1 = v; } else if (v > m2) m2 = v; }
        const float sc = m1 + m2; if (sc > best) { best = sc; gsel = g; } }
      float v1 = -1.f, v2 = -1.f; int i1 = 0, i2 = 0;
#pragma unroll
      for (int g = 0; g < 4; ++g) if (g == gsel) {
#pragma unroll
        for (int k = 0; k < 8; ++k) { const float v = pr[g * 8 + k] * inv; if (v > v1) { v2 = v1; i2 = i1; v1 = v; i1 = k; } else if (v > v2) { v2 = v; i2 = k; } } }
      e1 = gsel * 8 + i1; e2 = gsel * 8 + i2; const float gs = 1.0f / (v1 + v2); g1 = v1 * gs; g2 = v2 * gs;
      r1 = __hip_atomic_fetch_add(lcnt + e1, 1, __ATOMIC_RELAXED, __HIP_MEMORY_SCOPE_WORKGROUP); r2 = __hip_atomic_fetch_add(lcnt + e2, 1, __ATOMIC_RELAXED, __HIP_MEMORY_SCOPE_WORKGROUP);
    }
    __syncthreads();
    if (tid < 32) { const unsigned n = (unsigned)lcnt[tid]; gbase[tid] = n ? (int)atomicAdd(cnt + tid * CW_CNT_STRIDE, n) : 0; }
    __syncthreads();
    if (lane < 16) {
      const int p1 = gbase[e1] + r1, p2 = gbase[e2] + r2;
      tok_list[e1 * 32768 + p1] = tok; gate_list[e1 * 32768 + p1] = g1; tok_list[e2 * 32768 + p2] = tok; gate_list[e2 * 32768 + p2] = g2;
      tokslot[tok * 2] = e1 * 32768 + p1; tokslot[tok * 2 + 1] = e2 * 32768 + p2;
    }
    asm volatile("s_waitcnt lgkmcnt(0)" ::: "memory");
  }
}
DI int moe_tables(const Params& p, LAS int* T, int layer) {
  const unsigned* cnt = (const unsigned*)(WSP + WS_CTL) + CW_CNT + layer * 32 * CW_CNT_STRIDE;
  const int tid0 = opaque_tid();
  if (tid0 < 64) {
    const int lane = tid0, c = (lane < 32) ? (int)__hip_atomic_load(cnt + lane * CW_CNT_STRIDE, __ATOMIC_RELAXED, __HIP_MEMORY_SCOPE_AGENT) : 0;
    const int tiles = (c + 255) >> 8; int tp = tiles, sp = c;
#pragma unroll
    for (int d = 1; d < 32; d <<= 1) { const int a = __shfl_up(tp, d), b = __shfl_up(sp, d); if (lane >= d) { tp += a; sp += b; } }
    if (lane < 32) { T[lane] = tp - tiles; T[33 + lane] = sp - c; T[66 + lane] = c; }
    if (lane == 31) { T[32] = tp; T[65] = sp; } }
  __syncthreads();
  for (int t = opaque_tid(); t < T[32]; t += 512) { int e = 0; for (int k = 0; k < 32; ++k) e += (t >= T[k + 1]) ? 1 : 0; T[128 + t] = e; }
  __syncthreads();
  return T[32];
}
typedef float f32x2v __attribute__((ext_vector_type(2)));
DI void phase_combine(const Params& p, LAS int* T, int layer, bool make_h) {
  const float* sm = (const float*)(WSP + WS_SMALL);
  bf16_t* X = (bf16_t*)(WSP + WS_XR); const unsigned char* yb = (const unsigned char*)(WSP + WS_R0); const int* tokslot = (const int*)(WSP + WS_TOKSLOT);
  unsigned char* hout = WSP + WS_R3; float* fout = p.out;
  const int tid = opaque_tid(), lane = tid & 63, gw = blockIdx.x * 8 + (tid >> 6), NGW = gridDim.x * 8;
  for (int r0 = gw * 2; r0 < NTOK; r0 += NGW * 2) { const int b = r0 / SEQ;
    const float* g2 = sm + SM_MOD + (layer * 4 + b) * 6144 + 5 * 1024;
    u32x2 xv[2][4]; unsigned ya[2][4], yc[2][4];
#pragma unroll
    for (int q = 0; q < 2; ++q) { const int r = r0 + q;
      const int ca = tokslot[r * 2], cb = tokslot[r * 2 + 1];
      const int sa = T[33 + (ca >> 15)] + (ca & 32767), sb = T[33 + (cb >> 15)] + (cb & 32767);
      const bf16_t* xr = X + (size_t)r * D; const unsigned char* pa = yb + (size_t)sa * D; const unsigned char* pb = yb + (size_t)sb * D;
#pragma unroll
      for (int j = 0; j < 4; ++j) { const int c = 4 * lane + 256 * j; xv[q][j] = *(const u32x2*)(xr + c); ya[q][j] = *(const unsigned*)(pa + c); yc[q][j] = *(const unsigned*)(pb + c); } }
#pragma unroll
    for (int q = 0; q < 2; ++q) { const int r = r0 + q; float s = 0.f; f32x4 v[4];
#pragma unroll
      for (int j = 0; j < 4; ++j) { const int c = 4 * lane + 256 * j; const f32x4 gg = *(const f32x4*)(g2 + c) * 0.0625f; const u32x2 xx = xv[q][j];
        const f32x2v a0 = __builtin_amdgcn_cvt_pk_f32_fp8((int)ya[q][j], false), a1 = __builtin_amdgcn_cvt_pk_f32_fp8((int)ya[q][j], true);
        const f32x2v b0 = __builtin_amdgcn_cvt_pk_f32_fp8((int)yc[q][j], false), b1 = __builtin_amdgcn_cvt_pk_f32_fp8((int)yc[q][j], true);
        const f32x4 ys = {a0[0] + b0[0], a0[1] + b0[1], a1[0] + b1[0], a1[1] + b1[1]};
        const f32x4 x0 = {__uint_as_float(xx.x << 16), __uint_as_float(xx.x & 0xffff0000u), __uint_as_float(xx.y << 16), __uint_as_float(xx.y & 0xffff0000u)};
        v[j] = x0 + gg * ys;
        if (make_h) { u32x2 w; w.x = cvtpk(v[j][0], v[j][1]); w.y = cvtpk(v[j][2], v[j][3]); *(u32x2*)(X + (size_t)r * D + c) = w; }
        else *(f32x4*)(fout + (size_t)r * D + c) = v[j];
        s += (v[j][0] * v[j][0] + v[j][1] * v[j][1]) + (v[j][2] * v[j][2] + v[j][3] * v[j][3]); }
      if (make_h) { const float rstd = rsqrtf(wave_sum(s) * (1.f / D) + EPS);
        const float* g = p.n1g + (layer + 1) * D; const float* shift = sm + SM_MOD + ((layer + 1) * 4 + b) * 6144; const float* scale = shift + 1024;
#pragma unroll
        for (int j = 0; j < 4; ++j) { const int c = 4 * lane + 256 * j; const f32x4 gg = *(const f32x4*)(g + c), sh = *(const f32x4*)(shift + c), sc = *(const f32x4*)(scale + c);
          const f32x4 y = v[j] * rstd * gg * (sc + 1.0f) + sh; *(unsigned*)(hout + (size_t)r * D + c) = pk4_fp8(y[0], y[1], y[2], y[3]); } }
    }
  }
}
DI void phase_pool(const Params& p, LAS unsigned char* lds) {
  const unsigned char* U = WSP + WS_R2; unsigned char* Dd = WSP + WS_R3;
  const int tid = opaque_tid(), lane = tid & 63, wid = __builtin_amdgcn_readfirstlane(tid >> 6);
  const int c2 = tid;
  const int j = tid >> 7, hw = 1 << j;
  for (int tile = blockIdx.x; tile < NTOK / 32; tile += gridDim.x) {
    const int b = tile >> 8, t0 = (tile & 255) * 32;
    for (int r = wid; r < 48; r += 8) { const int row = t0 - 8 + r;
      if (row >= 0 && row < SEQ) __builtin_amdgcn_global_load_lds((const unsigned*)(U + (size_t)(b * SEQ + row) * D + lane * 16), (LAS unsigned*)(lds + r * 1024), 16, 0, 0); }
    asm volatile("s_waitcnt vmcnt(0)" ::: "memory"); __syncthreads();
    const LAS unsigned short* L = (const LAS unsigned short*)lds + c2;
    float s0 = 0.f, s1 = 0.f;
    { const int lo = (t0 - hw) > 0 ? (t0 - hw) : 0, hi = (t0 + hw) < SEQ ? (t0 + hw) : SEQ;
      for (int tt = lo; tt < hi; ++tt) { const f32x2v w = __builtin_amdgcn_cvt_pk_f32_fp8((int)L[(tt - t0 + 8) * 512], false); s0 += w[0]; s1 += w[1]; } }
#pragma unroll 4
    for (int i = 0; i < 32; ++i) { const int t = t0 + i;
      const int lo = (t - hw) > 0 ? (t - hw) : 0, hi = (t + hw) < SEQ ? (t + hw) : SEQ;
      const f32x2v wc = __builtin_amdgcn_cvt_pk_f32_fp8((int)L[(i + 8) * 512], false);
      const float inv = 1.0f / (float)(hi - lo);
      const int o = __builtin_amdgcn_cvt_pk_fp8_f32(s0 * inv - wc[0], s1 * inv - wc[1], 0, false);
      *(unsigned short*)(Dd + (size_t)(b * SEQ + t) * D + 2 * c2) = (unsigned short)o;
      if (t + hw < SEQ) { const f32x2v w = __builtin_amdgcn_cvt_pk_f32_fp8((int)L[(i + 8 + hw) * 512], false); s0 += w[0]; s1 += w[1]; }
      if (t - hw >= 0) { const f32x2v w = __builtin_amdgcn_cvt_pk_f32_fp8((int)L[(i + 8 - hw) * 512], false); s0 -= w[0]; s1 -= w[1]; }
    }
    __syncthreads();
  }
}

constexpr int LDS_BYTES = 163840;
constexpr int LDS_TAB = 131072;
constexpr int LDS_MISC = LDS_TAB + 2048;
constexpr int LDS_STG = LDS_TAB + 2304;
constexpr int NPHASE = 17;

__global__ void __launch_bounds__(512, 2) fwd_megakernel(Params p) {
  extern __shared__ __attribute__((aligned(16))) unsigned char lds_raw[];
  LAS unsigned char* lds = (LAS unsigned char*)lds_raw;
  LAS int* T = (LAS int*)(lds + LDS_TAB);
  cg::grid_group grid = cg::this_grid();
  { volatile LAS unsigned* MISC0 = (volatile LAS unsigned*)(lds + LDS_MISC);
    if (threadIdx.x < 4) MISC0[threadIdx.x] = 0u; }
  __syncthreads();
  volatile LAS unsigned* MISC = (volatile LAS unsigned*)(lds + LDS_MISC);
  (void)xcd_barrier_post((unsigned*)(WSP + WS_CTL) + CW_BAR, MISC);
#define XBAR() do { XcdBarrier xb_; xb_.bar = (unsigned*)(WSP + WS_CTL) + CW_BAR; xb_.x = xb_xcc_id(); xb_.st = (volatile LAS unsigned*)(lds + LDS_MISC); xcd_barrier(xb_); } while (0)
#define SMP ((const float*)(WSP + WS_SMALL))
#ifndef PHMASK
#define PHMASK 0xffffffffu
#endif
#ifndef REP_PHASE
#define REP_PHASE (-1)
#endif
#define IN(k) (((PHMASK >> ((k) & 31)) & 1u) != 0u)
#define REPS(k) for (int rep_ = 0; rep_ < (((k) == REP_PHASE) ? 2 : 1); ++rep_)
#ifndef USE_CG
#define SEAM(k) do { if (IN(k) && IN((k) + 1)) { XBAR(); } } while (0)
#else
#define SEAM(k) do { if (IN(k) && IN((k) + 1)) grid.sync(); } while (0)
#endif
  if (p.ph_lo == 0x7fffffff) grid.sync();
  if (IN(0)) REPS(0) { phase_mods(p, lds); __syncthreads(); }
  SEAM(0);
  if (IN(1)) REPS(1) { phase_hcat(p); phase_weights_small(p, lds); __syncthreads(); }
  SEAM(1);
  if (IN(2)) REPS(2) {
    EpiQKV E{EpiQK{WSP + WS_R1, WSP + WS_R2, p.qg, p.kg, SMP + SM_ROPE}, EpiVt{(unsigned char*)(WSP + WS_R3)}};
    SchedQKV S; S.init(WSP + WS_R0, WSP + WS_WQK, WSP + WS_WV);
    pg8::gemm_phase<EpiQKV, SchedQKV, pg8::PermQK, false, pg8::PermV, true, true>(lds, 1024, 1024, 1024, S, E);
    __syncthreads();
    { EpiW8 Ef{WSP + WS_WPF, 1024, 32.0f}; SchedFold Sf; Sf.init(WSP + WS_WPO, WSP + WS_WPG);
      pg8::gemm_phase<EpiW8, SchedFold, pg8::Perm8, false>(lds, 2048, 512, 256, Sf, Ef); __syncthreads(); }
    phase_weights_moe(p, lds);
  }
  SEAM(2);
  if (IN(3)) REPS(3) phase_attn(p, lds);
  SEAM(3);
  if (IN(4)) REPS(4) { EpiResid<true> E{p.x, (bf16_t*)(WSP + WS_XR), SMP + SM_MOD + 2 * 1024, (float*)(WSP + WS_ROWSS)};
    SchedGrid S; S.init(WSP + WS_R0, WSP + WS_WO, 1024, 1024, 128, 4);
    pg8::gemm_phase<EpiResid<true>, SchedGrid, pg8::Perm8, false, pg8::Perm8, false, true>(lds, 1024, 1024, 1024, S, E); }
  SEAM(4);
  for (int layer = 0; layer < 2; ++layer) {
    const int P = 5 + layer * 8;
    if (IN(P)) phase_router(p, lds, layer);
    SEAM(P);
    if (IN(P + 1)) REPS(P + 1) { const int nt = moe_tables(p, T, layer);
      EpiAct E{(bf16_t*)(WSP + WS_R2)};
      typedef SchedMoe<true, 1024 * 1024, 256 * 1024, 1024> SM1; SM1 S; S.T = T; S.A0 = (const char*)(WSP + WS_R1); S.W0 = (const char*)(WSP + WS_WGU + (size_t)layer * 32 * MiB);
      S.tok = (const int*)(WSP + WS_LIST); S.dl.init(nt * 4);
      { LAS int* tl = (LAS int*)(lds + LDS_TAB + 2304); S.tokl = tl; const int t_ = opaque_tid();
        for (int i = 0; i < 6; ++i) { pg8::Unit u_; if (!S.next(i, u_)) break; if (t_ < 256) tl[i * 256 + t_] = S.tok[u_.i3 + t_]; }
        __syncthreads(); }
      pg8::gemm_phase<EpiAct, SM1, pg8::Perm8, true, pg8::Perm8, false, true, true>(lds, 1024, 1024, 1024, S, E); }
    SEAM(P + 1);
    if (IN(P + 2)) REPS(P + 2) { const int nt = T[32];
      EpiY E{(unsigned char*)(WSP + WS_R0), (const LAS float*)(lds + LDS_TAB + 2304)};
      typedef SchedMoe<false, 1024 * 512, 256 * 512, 512> SM2; SM2 S; S.T = T; S.A0 = (const char*)(WSP + WS_R2); S.W0 = (const char*)(WSP + WS_WD + (size_t)layer * 16 * MiB);
      S.tok = nullptr; S.tokl = nullptr; S.dl.init(nt * 4);
      { LAS float* gl_ = (LAS float*)(lds + LDS_TAB + 2304); const float* gsrc = (const float*)(WSP + WS_LIST + 4 * MiB); const int t_ = opaque_tid();
        for (int i = 0; i < 6; ++i) { pg8::Unit u_; if (!S.next(i, u_)) break; if (t_ < 256) gl_[i * 256 + t_] = gsrc[u_.i3 + t_]; }
        __syncthreads(); }
      pg8::gemm_phase<EpiY, SM2, pg8::Perm8, false, pg8::Perm8, false, true, true>(lds, 512, 512, 512, S, E); }
    SEAM(P + 2);
    if (IN(P + 3)) { phase_combine(p, T, layer, layer == 0); }
    if (layer == 0) {
      SEAM(8);
      if (IN(9)) REPS(9) { EpiW8 E{WSP + WS_R2, 1024, 1.0f};
        SchedGrid S; S.init(WSP + WS_R3, WSP + WS_WPI, 1024, 1024, 128, 4);
        pg8::gemm_phase<EpiW8, SchedGrid, pg8::Perm8, false, pg8::Perm8, false, true>(lds, 1024, 1024, 1024, S, E); }
      SEAM(9);
      if (IN(10)) REPS(10) phase_pool(p, lds);
      SEAM(10);
      if (IN(12)) { EpiResid<false> E{nullptr, (bf16_t*)(WSP + WS_XR), SMP + SM_MOD + 4 * 6144 + 2 * 1024, (float*)(WSP + WS_ROWSS)};
        SchedGrid S; S.init(WSP + WS_R3, WSP + WS_WPF, 1024, 1024, 128, 4);
        pg8::gemm_phase<EpiResid<false>, SchedGrid, pg8::Perm8, false, pg8::Perm8, false, true>(lds, 1024, 1024, 1024, S, E); }
      SEAM(12);
    }
  }
#undef IN
#undef SEAM
#undef SMP
}

extern "C" void kernel_launch(void* const* d_in, const int* in_sizes, int n_in, void* d_out, int out_size,
                              void* d_ws, size_t ws_size, hipStream_t stream) {
  static int grid_blocks = 0;
  if (grid_blocks == 0) {
    int dev = 0, cus = 0, per_cu = 0;
    if (n_in != 26 || out_size != NTOK * D || ws_size < WS_END) { fprintf(stderr, "kernel_launch: unexpected shapes (n_in %d out %d ws %zu)\n", n_in, out_size, ws_size); grid_blocks = -1; return; }
    (void)hipGetDevice(&dev); (void)hipDeviceGetAttribute(&cus, hipDeviceAttributeMultiprocessorCount, dev);
    (void)hipFuncSetAttribute((const void*)fwd_megakernel, hipFuncAttributeMaxDynamicSharedMemorySize, LDS_BYTES);
    (void)hipOccupancyMaxActiveBlocksPerMultiprocessor(&per_cu, (const void*)fwd_megakernel, 512, LDS_BYTES);
    if (per_cu < 1) fprintf(stderr, "kernel_launch: occupancy query says %d\n", per_cu);
    (void)hipGetLastError();
    grid_blocks = cus;
  }
  if (grid_blocks < 0) return;
  (void)hipMemsetAsync((char*)d_ws + WS_CTL, 0, 32768, stream);
  Params p{};
  const float** pp = (const float**)&p;
  for (int i = 0; i < 26; ++i) pp[i] = (const float*)d_in[i];
  p.out = (float*)d_out; p.ws = (unsigned char*)d_ws; p.ph_lo = 0; p.ph_hi = 0;
  void* args[] = {&p};
  hipError_t e = hipLaunchCooperativeKernel((void*)fwd_megakernel, dim3(grid_blocks), dim3(512), args, LDS_BYTES, stream);
  if (e != hipSuccess) fprintf(stderr, "cooperative launch failed: %s (grid %d)\n", hipGetErrorString(e), grid_blocks);
}
```
